# Optimizing an MI355X kernel written in HIP

```python
import jax, jax.numpy as jnp
from jax import lax
import numpy as np

D_MODEL = 1024
BATCH = 8
SEQ = 4096
DEPTH = 1

MIX_WIDTH = D_MODEL
POOL_WIDTH = MIX_WIDTH // 2
POOL_WINDOWS = (2, 4, 8, 16)
N_POOL_GROUPS = len(POOL_WINDOWS)
POOL_GROUP = POOL_WIDTH // N_POOL_GROUPS
NA_WIDTH = MIX_WIDTH - POOL_WIDTH
NA_HEAD_DIM = 64
NA_HEADS = NA_WIDTH // NA_HEAD_DIM
GRID_W = 64
WIN_ROWS = 8
WIN_COLS = 16
COL_BLOCK = 16
COL_BAND = 2 * WIN_COLS
N_COL_BLOCKS = GRID_W // COL_BLOCK
D_FF = 4 * D_MODEL
IN_WIDTH = POOL_WIDTH + 3 * NA_WIDTH
EPS = 1e-6

kernel_name = "hybrid_pool_neighbourhood_attn_block"


def rmsnorm(x, g):
    x32 = x.astype(jnp.float32)
    y = x32 * lax.rsqrt(jnp.mean(jnp.square(x32), axis=-1, keepdims=True) + EPS)
    return y.astype(x.dtype) * g


def pool_mixer(u, w_pool, pool_scale):
    B, T, _ = u.shape
    u32 = u.astype(jnp.float32)
    cs = jnp.concatenate([jnp.zeros((B, 1, POOL_WIDTH), jnp.float32),
                          jnp.cumsum(u32, axis=1)], axis=1)
    t = jnp.arange(T)
    outs = []
    for gi, w in enumerate(POOL_WINDOWS):
        sl = slice(gi * POOL_GROUP, (gi + 1) * POOL_GROUP)
        lo = jnp.clip(t - w // 2, 0, T)
        hi = jnp.clip(t - w // 2 + w, 0, T)
        cs_g = cs[:, :, sl]
        win_sum = jnp.take(cs_g, hi, axis=1) - jnp.take(cs_g, lo, axis=1)
        mean = win_sum / (hi - lo).astype(jnp.float32)[None, :, None]
        outs.append(mean - u32[:, :, sl])
    pooled = jnp.stack(outs, axis=2).astype(u.dtype)
    mixed = jnp.einsum('btgc,gcd->btgd', pooled, w_pool)
    return mixed.reshape(B, T, POOL_WIDTH) * pool_scale


def neighbourhood_attention(q, k, v, rpb):
    B, T, H, dh = q.shape
    rows = T // GRID_W
    kr = min(WIN_ROWS, rows)
    scale = dh ** -0.5

    def to_grid(a):
        return a.reshape(B, rows, GRID_W, H, dh).transpose(0, 3, 1, 2, 4)

    q_g, k_g, v_g = to_grid(q), to_grid(k), to_grid(v)

    cols = np.arange(GRID_W)
    c0 = np.clip(cols - WIN_COLS // 2, 0, GRID_W - WIN_COLS)
    band_start = np.clip(np.arange(N_COL_BLOCKS) * COL_BLOCK - WIN_COLS // 2, 0, GRID_W - COL_BAND)
    key_cols = band_start[:, None] + np.arange(COL_BAND)
    q_cols = (np.arange(N_COL_BLOCKS) * COL_BLOCK)[:, None] + np.arange(COL_BLOCK)
    qc0 = c0[q_cols][:, :, None]
    kc = key_cols[:, None, :]
    col_ok = (kc >= qc0) & (kc < qc0 + WIN_COLS)
    dc_idx = np.clip(kc - q_cols[:, :, None] + WIN_COLS - 1, 0, 2 * WIN_COLS - 2)
    bias_c = rpb[:, :, dc_idx]
    col_ok_b = jnp.asarray(col_ok)[:, :, None, :]

    def row_block(r):
        r0 = jnp.clip(r - kr // 2, 0, rows - kr)
        k_rows = lax.dynamic_slice_in_dim(k_g, r0, kr, axis=2)
        v_rows = lax.dynamic_slice_in_dim(v_g, r0, kr, axis=2)
        k_band = jnp.take(k_rows, key_cols, axis=3)
        v_band = jnp.take(v_rows, key_cols, axis=3)
        q_row = lax.dynamic_index_in_dim(q_g, r, axis=2, keepdims=False)
        q_row = q_row.reshape(B, H, N_COL_BLOCKS, COL_BLOCK, dh)
        s = jnp.einsum('bhjqd,bhijkd->bhjqik', q_row, k_band).astype(jnp.float32) * scale
        dr_idx = r0 + jnp.arange(kr) - r + (WIN_ROWS - 1)
        bias = jnp.take(bias_c, dr_idx, axis=1).transpose(0, 2, 3, 1, 4)
        s = s + bias[None].astype(jnp.float32)
        s = jnp.where(col_ok_b, s, -jnp.inf)
        p = jax.nn.softmax(s.reshape(B, H, N_COL_BLOCKS, COL_BLOCK, kr * COL_BAND), axis=-1)
        p = p.reshape(B, H, N_COL_BLOCKS, COL_BLOCK, kr, COL_BAND).astype(v.dtype)
        o = jnp.einsum('bhjqik,bhijkd->bhjqd', p, v_band)
        return o.reshape(B, H, GRID_W, dh)

    out = lax.map(row_block, jnp.arange(rows))
    return out.transpose(1, 0, 3, 2, 4).reshape(B, T, H * dh)


def setup_inputs(seed: int = 0) -> dict:
    key = jax.random.key(seed)
    ks = jax.random.split(key, 12)
    f32 = jnp.float32
    x = jax.random.normal(ks[0], (BATCH, SEQ, D_MODEL), f32)
    norm_mix_g = 1.0 + 0.02 * jax.random.normal(ks[1], (DEPTH, D_MODEL), f32)
    w_in = jax.random.normal(ks[2], (DEPTH, D_MODEL, IN_WIDTH), f32) * D_MODEL ** -0.5
    w_pool = jax.random.normal(ks[3], (DEPTH, N_POOL_GROUPS, POOL_GROUP, POOL_GROUP), f32) * POOL_GROUP ** -0.5
    pool_scale = 1.0 + 0.1 * jax.random.normal(ks[4], (DEPTH, POOL_WIDTH), f32)
    rpb = 0.5 * jax.random.normal(ks[5], (DEPTH, NA_HEADS, 2 * WIN_ROWS - 1, 2 * WIN_COLS - 1), f32)
    w_out = jax.random.normal(ks[6], (DEPTH, MIX_WIDTH, D_MODEL), f32) * MIX_WIDTH ** -0.5
    norm_mlp_g = 1.0 + 0.02 * jax.random.normal(ks[7], (DEPTH, D_MODEL), f32)
    w_up = jax.random.normal(ks[8], (DEPTH, D_MODEL, D_FF), f32) * D_MODEL ** -0.5
    w_down = jax.random.normal(ks[9], (DEPTH, D_FF, D_MODEL), f32) * D_FF ** -0.5
    final_g = 1.0 + 0.02 * jax.random.normal(ks[10], (D_MODEL,), f32)
    return {"x": x, "norm_mix_g": norm_mix_g, "w_in": w_in, "w_pool": w_pool,
            "pool_scale": pool_scale, "rpb": rpb, "w_out": w_out,
            "norm_mlp_g": norm_mlp_g, "w_up": w_up, "w_down": w_down,
            "final_g": final_g}


def reference(x, norm_mix_g, w_in, w_pool, pool_scale, rpb, w_out,
              norm_mlp_g, w_up, w_down, final_g):
    B, T, _ = x.shape
    for l in range(DEPTH):
        h = rmsnorm(x, norm_mix_g[l])
        proj = h @ w_in[l]
        u = proj[..., :POOL_WIDTH]
        q, k, v = jnp.split(proj[..., POOL_WIDTH:], 3, axis=-1)
        q = q.reshape(B, T, NA_HEADS, NA_HEAD_DIM)
        k = k.reshape(B, T, NA_HEADS, NA_HEAD_DIM)
        v = v.reshape(B, T, NA_HEADS, NA_HEAD_DIM)
        a = pool_mixer(u, w_pool[l], pool_scale[l])
        b = neighbourhood_attention(q, k, v, rpb[l])
        x = x + jnp.concatenate([a, b], axis=-1) @ w_out[l]
        h = rmsnorm(x, norm_mlp_g[l])
        x = x + jnp.square(jax.nn.relu(h @ w_up[l])) @ w_down[l]
    return rmsnorm(x, final_g)
```

```cpp
#define MK_N_LAUNCHES 1
#define DUP_PHASE -1
#include <hip/hip_runtime.h>
#include <hip/hip_cooperative_groups.h>
#include <cstdio>
#include <cstdint>
#include <cmath>
namespace cg = cooperative_groups;
namespace pg8 {
#define PG8_LAS __attribute__((address_space(3)))
typedef unsigned short bf16_t;
typedef short bf16x8 __attribute__((ext_vector_type(8)));
typedef float f32x4 __attribute__((ext_vector_type(4)));
typedef unsigned u32x4 __attribute__((ext_vector_type(4)));
constexpr int BM = 256, BK = 64, HALF = 128, HTB = HALF * BK * 2  , STAGE_BYTES = 8 * HTB, NXCD = 8, WGM = 8;

__host__ __device__ __forceinline__ int lds_byte(int r, int c) { const int st = (r >> 4) * 2 + (c >> 5), rr = r & 15, cc = c & 31, ob = rr * 64 + cc * 2; return st * 1024 + (ob ^ (((ob >> 9) & 1) << 5)); }
__host__ __device__ __forceinline__ void stage_rc(int b, int& R, int& C) { const int st = b / 1024, sb = b % 1024, swz = sb ^ (((sb >> 9) & 1) << 5); R = (st >> 1) * 16 + swz / 64; C = (st & 1) * 32 + (swz % 64) / 2; }
__host__ __device__ __forceinline__ int perm32(int rho) { const int n = rho >> 4, i = rho & 15; return 8 * (i >> 2) + 4 * n + (i & 3); }

struct Unit { int pm, pn; };
struct Gemm { const bf16_t* A; const bf16_t* Bt; int M, N, K, lda; };

struct StaticOrder {
    int nM, nN, nwg, G, c;
    __host__ __device__ void init(int M, int N, int G_, int c_) { nM = M / BM; nN = N / BM; nwg = nM * nN; G = G_; c = c_; }
    __host__ __device__ bool next(int i, Unit& u) const {
        const long L = (long)i * G + c; if (L >= nwg) return false;
        int wgid = (int)L; { const int q = nwg / NXCD, r = nwg % NXCD, xcd = wgid % NXCD, off = wgid / NXCD; wgid = (xcd < r ? xcd * (q + 1) : r * (q + 1) + (xcd - r) * q) + off; }
        const int nig = WGM * nN, gid = wgid / nig, fm = gid * WGM, gsz = (nM - fm) < WGM ? (nM - fm) : WGM;
        u.pm = fm + ((wgid % nig) % gsz); u.pn = (wgid % nig) / gsz; return true;
    }
    __device__ __forceinline__ void a_ready(const Unit&) const {}
    __device__ __forceinline__ void done(const Unit&) const {}
};

typedef float f32x2c __attribute__((ext_vector_type(2))); typedef __bf16 bf16x2c __attribute__((ext_vector_type(2)));
__device__ __forceinline__ unsigned cvt_pk_bf16(float lo, float hi) { const f32x2c v = {lo, hi}; const bf16x2c b = __builtin_convertvector(v, bf16x2c); return __builtin_bit_cast(unsigned, b); }
typedef float f32x2 __attribute__((ext_vector_type(2)));
__device__ __forceinline__ float bfl(unsigned w) { return __builtin_bit_cast(float, w << 16); }
__device__ __forceinline__ float bfh(unsigned w) { return __builtin_bit_cast(float, w & 0xffff0000u); }
__device__ __forceinline__ u32x4 pack8(const f32x4 a, const f32x4 b) { u32x4 w; w.x = cvt_pk_bf16(a[0], a[1]); w.y = cvt_pk_bf16(a[2], a[3]); w.z = cvt_pk_bf16(b[0], b[1]); w.w = cvt_pk_bf16(b[2], b[3]); return w; }

struct EpiProj {
    static constexpr bool PERM = true, PERM_A = false, SWAP = false, AFTER_DRAIN = false;
    bf16_t* O; int ldc; bf16_t* KIMG;
    __device__ __forceinline__ void operator()(const f32x4 (&acc)[2][2][4][2], const Unit& u, int wr, int wc, int fr, int fq) const {
        const int row0 = u.pm * BM + wr * 64 + fr, col0 = u.pn * BM + wc * 32 + 8 * fq;
        if (u.pn < 4) {
            const float qs = (u.pn >= 2) ? 0.125f * 1.4426950408889634f : 1.0f;
#pragma unroll
            for (int ai = 0; ai < 2; ++ai)
#pragma unroll
                for (int m = 0; m < 4; ++m) { bf16_t* rowp = O + (size_t)(row0 + ai * HALF + m * 16) * ldc + col0;
#pragma unroll
                    for (int bj = 0; bj < 2; ++bj) *(u32x4*)(rowp + bj * HALF) = pack8(acc[ai][bj][m][0] * qs, acc[ai][bj][m][1] * qs); }
        } else {
            const int slot = (wc & 1) * 4 + fq;
#pragma unroll
            for (int ai = 0; ai < 2; ++ai)
#pragma unroll
                for (int m = 0; m < 4; ++m) { const int tok = row0 + ai * HALF + m * 16, b = tok >> 12, rc = tok & 4095, cg = tok & 63;
#pragma unroll
                    for (int bj = 0; bj < 2; ++bj) { const int h = (u.pn - 4) * 4 + bj * 2 + (wc >> 1);
                        bf16_t* p = KIMG + ((((size_t)(b * 8 + h) * 4096 + rc) * 8 + (slot ^ ((cg >> 1) & 7))) * 8);
                        *(u32x4*)p = pack8(acc[ai][bj][m][0], acc[ai][bj][m][1]); } }
        }
    }
};
struct EpiVT {
    static constexpr bool PERM = false, PERM_A = true, SWAP = true, AFTER_DRAIN = false;
    bf16_t* VIMG;
    __device__ __forceinline__ void operator()(const f32x4 (&acc)[2][2][4][2], const Unit& u, int wr, int wc, int fr, int fq) const {
        const int b = u.pm >> 4, t0 = (u.pm & 15) * 256 + wr * 64 + 8 * fq, c0 = u.pn * BM + wc * 32 + fr;
#pragma unroll
        for (int bj = 0; bj < 2; ++bj)
#pragma unroll
            for (int n = 0; n < 2; ++n) { const int c = c0 + bj * HALF + n * 16, h = c >> 6, dh = c & 63;
#pragma unroll
                for (int ai = 0; ai < 2; ++ai)
#pragma unroll
                    for (int mp = 0; mp < 2; ++mp) { const int t = t0 + ai * HALF + mp * 32, rowcb = t >> 3;
                        bf16_t* p = VIMG + (((size_t)(b * 8 + h) * 512 + rowcb) * 64 + (dh ^ (4 * (rowcb & 1)))) * 8;
                        *(u32x4*)p = pack8(acc[ai][bj][2 * mp][n], acc[ai][bj][2 * mp + 1][n]); } }
    }
};
struct EpiRes1 {
    static constexpr bool PERM = true, PERM_A = false, SWAP = false, AFTER_DRAIN = false;
    const float* X; bf16_t* X1B; float* SSQ;
    __device__ __forceinline__ void operator()(const f32x4 (&acc)[2][2][4][2], const Unit& u, int wr, int wc, int fr, int fq) const {
        const int row0 = u.pm * BM + wr * 64 + fr, col0 = u.pn * BM + wc * 32 + 8 * fq;
#pragma unroll
        for (int ai = 0; ai < 2; ++ai)
#pragma unroll
            for (int m = 0; m < 4; ++m) { const int row = row0 + ai * HALF + m * 16; const size_t off = (size_t)row * 1024 + col0; float ss = 0.f;
#pragma unroll
                for (int bj = 0; bj < 2; ++bj) { const f32x4 xa = *(const f32x4*)(X + off + bj * HALF), xb = *(const f32x4*)(X + off + bj * HALF + 4);
                    const f32x4 v0 = acc[ai][bj][m][0] + xa, v1 = acc[ai][bj][m][1] + xb;
                    *(u32x4*)(X1B + off + bj * HALF) = pack8(v0, v1);
                    ss += (v0[0] * v0[0] + v0[1] * v0[1]) + (v0[2] * v0[2] + v0[3] * v0[3]) + (v1[0] * v1[0] + v1[1] * v1[1]) + (v1[2] * v1[2] + v1[3] * v1[3]); }
                ss += __shfl_xor(ss, 16); ss += __shfl_xor(ss, 32);
                if (fq == 0) SSQ[(size_t)row * 16 + u.pn * 4 + wc] = ss; }
    }
};
struct EpiRes1N {
    static constexpr bool PERM = true, PERM_A = false, SWAP = false, AFTER_DRAIN = false;
    const bf16_t* XN; bf16_t* X1B; float* SSQ; const PG8_LAS float* RT; const PG8_LAS float* GT; int PM0;
    __device__ __forceinline__ void operator()(const f32x4 (&acc)[2][2][4][2], const Unit& u, int wr, int wc, int fr, int fq) const {
        const int row0 = u.pm * BM + wr * 64 + fr, col0 = u.pn * BM + wc * 32 + 8 * fq;
        const PG8_LAS float* rt = RT + ((u.pm == PM0) ? 0 : 256) + wr * 64 + fr;
        float ri[8]; f32x4 gi[2][2];
#pragma unroll
        for (int k = 0; k < 8; ++k) ri[k] = rt[(k >> 2) * HALF + (k & 3) * 16];
#pragma unroll
        for (int bj = 0; bj < 2; ++bj) { gi[bj][0] = *(const PG8_LAS f32x4*)(GT + col0 + bj * HALF); gi[bj][1] = *(const PG8_LAS f32x4*)(GT + col0 + bj * HALF + 4); }
        __builtin_amdgcn_sched_barrier(0);
#pragma unroll
        for (int ai = 0; ai < 2; ++ai)
#pragma unroll
            for (int m = 0; m < 4; ++m) { const int row = row0 + ai * HALF + m * 16; const size_t off = (size_t)row * 1024 + col0; float ss = 0.f; const float rinv = ri[ai * 4 + m];
#pragma unroll
                for (int bj = 0; bj < 2; ++bj) { const u32x4 xw = *(const u32x4*)(XN + off + bj * HALF);
                    const f32x4 xa = (f32x4){bfl(xw.x), bfh(xw.x), bfl(xw.y), bfh(xw.y)} * rinv * gi[bj][0], xb = (f32x4){bfl(xw.z), bfh(xw.z), bfl(xw.w), bfh(xw.w)} * rinv * gi[bj][1];
                    const f32x4 v0 = acc[ai][bj][m][0] + xa, v1 = acc[ai][bj][m][1] + xb;
                    *(u32x4*)(X1B + off + bj * HALF) = pack8(v0, v1);
                    ss += (v0[0] * v0[0] + v0[1] * v0[1]) + (v0[2] * v0[2] + v0[3] * v0[3]) + (v1[0] * v1[0] + v1[1] * v1[1]) + (v1[2] * v1[2] + v1[3] * v1[3]); }
                ss += __shfl_xor(ss, 16); ss += __shfl_xor(ss, 32);
                if (fq == 0) SSQ[(size_t)row * 16 + u.pn * 4 + wc] = ss; }
    }
};
struct EpiUp {
    static constexpr bool PERM = true, PERM_A = false, SWAP = false, AFTER_DRAIN = false;
    static constexpr int HP = 4096 + 64;
    bf16_t* H; const float* SSQ; const PG8_LAS float* RL; int PM0;
    __device__ __forceinline__ void operator()(const f32x4 (&acc)[2][2][4][2], const Unit& u, int wr, int wc, int fr, int fq) const {
        const int row0 = u.pm * BM + wr * 64 + fr, col0 = u.pn * BM + wc * 32 + 8 * fq;
        const PG8_LAS float* rl = RL + ((u.pm == PM0) ? 0 : 256) + wr * 64 + fr;
#pragma unroll
        for (int ai = 0; ai < 2; ++ai)
#pragma unroll
            for (int m = 0; m < 4; ++m) { const int row = row0 + ai * HALF + m * 16; float r;
                if (PM0 >= 0) r = rl[ai * HALF + m * 16];
                else { const f32x4* sp = (const f32x4*)(SSQ + (size_t)row * 16); const f32x4 p = (sp[0] + sp[1]) + (sp[2] + sp[3]); r = __builtin_amdgcn_rsqf(((p[0] + p[1]) + (p[2] + p[3])) * (1.0f / 1024.0f) + 1e-6f); }
                bf16_t* rowp = H + (size_t)row * HP + col0;
#pragma unroll
                for (int bj = 0; bj < 2; ++bj) { f32x4 v0 = acc[ai][bj][m][0] * r, v1 = acc[ai][bj][m][1] * r;
#pragma unroll
                    for (int e = 0; e < 4; ++e) { const float a = fmaxf(v0[e], 0.f), c = fmaxf(v1[e], 0.f); v0[e] = a * a; v1[e] = c * c; }
                    *(u32x4*)(rowp + bj * HALF) = pack8(v0, v1); } }
    }
};
struct EpiRes2 {
    static constexpr bool PERM = true, PERM_A = false, SWAP = false, AFTER_DRAIN = false;
    bf16_t* X1B; float* SSQ;
    __device__ __forceinline__ void operator()(const f32x4 (&acc)[2][2][4][2], const Unit& u, int wr, int wc, int fr, int fq) const {
        const int row0 = u.pm * BM + wr * 64 + fr, col0 = u.pn * BM + wc * 32 + 8 * fq;
#pragma unroll
        for (int ai = 0; ai < 2; ++ai)
#pragma unroll
            for (int m = 0; m < 4; ++m) { const int row = row0 + ai * HALF + m * 16; const size_t off = (size_t)row * 1024 + col0; float ss = 0.f;
#pragma unroll
                for (int bj = 0; bj < 2; ++bj) { const u32x4 xw = *(const u32x4*)(X1B + off + bj * HALF);
                    const f32x4 xa = {bfl(xw.x), bfh(xw.x), bfl(xw.y), bfh(xw.y)}, xb = {bfl(xw.z), bfh(xw.z), bfl(xw.w), bfh(xw.w)};
                    const f32x4 v0 = acc[ai][bj][m][0] + xa, v1 = acc[ai][bj][m][1] + xb;
                    *(u32x4*)(X1B + off + bj * HALF) = pack8(v0, v1);
                    ss += (v0[0] * v0[0] + v0[1] * v0[1]) + (v0[2] * v0[2] + v0[3] * v0[3]) + (v1[0] * v1[0] + v1[1] * v1[1]) + (v1[2] * v1[2] + v1[3] * v1[3]); }
                ss += __shfl_xor(ss, 16); ss += __shfl_xor(ss, 32);
                if (fq == 0) SSQ[(size_t)row * 16 + u.pn * 4 + wc] = ss; }
    }
};

struct EpiY {
    static constexpr bool PERM = true, PERM_A = false, SWAP = false, AFTER_DRAIN = false;
    bf16_t* Y;
    __device__ __forceinline__ void operator()(const f32x4 (&acc)[2][2][4][2], const Unit& u, int wr, int wc, int fr, int fq) const {
        const int row0 = u.pm * BM + wr * 64 + fr, col0 = u.pn * BM + wc * 32 + 8 * fq;
#pragma unroll
        for (int ai = 0; ai < 2; ++ai)
#pragma unroll
            for (int m = 0; m < 4; ++m) { bf16_t* rowp = Y + (size_t)(row0 + ai * HALF + m * 16) * 1024 + col0;
#pragma unroll
                for (int bj = 0; bj < 2; ++bj) *(u32x4*)(rowp + bj * HALF) = pack8(acc[ai][bj][m][0], acc[ai][bj][m][1]); }
    }
};
template <class Epi, class Sched, bool ALIGN_EPI = false, bool SP2 = false>
__device__ __forceinline__ void gemm_phase(PG8_LAS unsigned char* lds, const Gemm g, const Sched& S, const Epi& E) {
    const int tid = threadIdx.x, wid = __builtin_amdgcn_readfirstlane(tid >> 6), lane = tid & 63, wr = wid >> 2, wc = wid & 3, fr = lane & 15, fq = lane >> 4;
    const int K = g.K, nt = K / BK;
    unsigned voffA[2], voffB[2];
#pragma unroll
    for (int i = 0; i < 2; ++i) { int R, C; stage_rc(tid * 16 + i * 8192, R, C); const int Rb = Epi::PERM ? ((R & ~31) + perm32(R & 31)) : R; const int Ra = Epi::PERM_A ? ((R & ~31) + perm32(R & 31)) : R;
        voffA[i] = (unsigned)(Ra * g.lda + C) * 2u; voffB[i] = (unsigned)(Rb * K + C) * 2u; }
    const size_t kstep = (size_t)(BK * 2);
    const size_t hstep = (size_t)HALF * K * 2;
    const size_t tstep = 2 * hstep;
    const size_t hstepA = (size_t)HALF * g.lda * 2, tstepA = 2 * hstepA;
    const unsigned ldsw = (unsigned)wid * 1024u;
    const int aoff = lds_byte(wr * 64 + fr, fq * 8), boff = lds_byte(wc * 32 + fr, fq * 8);
#define PG8_SA(b, h) (((b) * 2 + (h)) * HTB)
#define PG8_SB(b, h) ((4 + (b) * 2 + (h)) * HTB)
#define PG8_STAGE(bufoff, gbase, voff) do { _Pragma("unroll") for (int _i = 0; _i < 2; ++_i) \
        __builtin_amdgcn_global_load_lds((const unsigned*)((const char*)(gbase) + (voff)[_i]), (PG8_LAS unsigned*)(lds + (bufoff) + ldsw + _i * 8192), 16, 0, 0); } while (0)
#define PG8_LDA(dst, b, h) do { _Pragma("unroll") for (int m = 0; m < 4; ++m) _Pragma("unroll") for (int k = 0; k < 2; ++k) dst[m][k] = *(const PG8_LAS bf16x8*)(lds + PG8_SA(b, h) + aoff + m * 2048 + k * 1024); } while (0)
#define PG8_LDB(dst, b, h) do { _Pragma("unroll") for (int n = 0; n < 2; ++n) _Pragma("unroll") for (int k = 0; k < 2; ++k) dst[n][k] = *(const PG8_LAS bf16x8*)(lds + PG8_SB(b, h) + boff + n * 2048 + k * 1024); } while (0)
#define PG8_MMA(ai, bj, At, Bt) do { __builtin_amdgcn_s_setprio(1); _Pragma("unroll") for (int m = 0; m < 4; ++m) _Pragma("unroll") for (int n = 0; n < 2; ++n) _Pragma("unroll") for (int k = 0; k < 2; ++k) \
        acc[ai][bj][m][n] = Epi::SWAP ? __builtin_amdgcn_mfma_f32_16x16x32_bf16(At[m][k], Bt[n][k], acc[ai][bj][m][n], 0, 0, 0) : __builtin_amdgcn_mfma_f32_16x16x32_bf16(Bt[n][k], At[m][k], acc[ai][bj][m][n], 0, 0, 0); __builtin_amdgcn_s_setprio(0); } while (0)
#define PG8_WAIT_V(n) asm volatile("s_waitcnt vmcnt(" #n ")" ::: "memory")
#define PG8_WAIT_L(n) asm volatile("s_waitcnt lgkmcnt(" #n ")" ::: "memory")
#define PG8_BAR __builtin_amdgcn_s_barrier()
#define PG8_SCHED __builtin_amdgcn_sched_barrier(0)
    Unit cur, nxt; int ui = 0;
    if (!S.next(0, cur)) return;
    f32x4 acc[2][2][4][2];
#pragma unroll
    for (int a = 0; a < 2; ++a)
#pragma unroll
        for (int b = 0; b < 2; ++b)
#pragma unroll
            for (int m = 0; m < 4; ++m)
#pragma unroll
                for (int n = 0; n < 2; ++n) acc[a][b][m][n] = (f32x4){0.f, 0.f, 0.f, 0.f};
    bf16x8 At[4][2], B0[2][2], B1[2][2];
    const char* cA = (const char*)g.A + (size_t)cur.pm * tstepA; const char* cB = (const char*)g.Bt + (size_t)cur.pn * tstep;
    S.a_ready(cur);
    if constexpr (SP2) {
        PG8_STAGE(PG8_SB(0, 0), cB, voffB); PG8_STAGE(PG8_SB(0, 1), cB + hstep, voffB); PG8_STAGE(PG8_SA(0, 0), cA, voffA); PG8_STAGE(PG8_SA(0, 1), cA + hstepA, voffA);
        if (wr == 1) PG8_BAR;
        PG8_WAIT_V(2); PG8_BAR;
        PG8_STAGE(PG8_SB(1, 0), cB + kstep, voffB); PG8_STAGE(PG8_SA(1, 0), cA + kstep, voffA); PG8_STAGE(PG8_SB(1, 1), cB + hstep + kstep, voffB);
        PG8_WAIT_V(6); PG8_BAR;
    } else {
        PG8_STAGE(PG8_SB(0, 0), cB, voffB); PG8_STAGE(PG8_SA(0, 0), cA, voffA); PG8_STAGE(PG8_SB(0, 1), cB + hstep, voffB); PG8_STAGE(PG8_SA(0, 1), cA + hstepA, voffA);
        if (wr == 1) PG8_BAR;
        PG8_WAIT_V(4); PG8_BAR;
        PG8_STAGE(PG8_SB(1, 0), cB + kstep, voffB); PG8_STAGE(PG8_SA(1, 0), cA + kstep, voffA); PG8_STAGE(PG8_SB(1, 1), cB + hstep + kstep, voffB);
        PG8_WAIT_V(6); PG8_BAR;
    }
    for (;;) {
        const bool has_next = S.next(ui + 1, nxt);
        const char* nA = has_next ? (const char*)g.A + (size_t)nxt.pm * tstepA : cA; const char* nB = has_next ? (const char*)g.Bt + (size_t)nxt.pn * tstep : cB;
        for (int t = 0; t < nt; t += 2) {
            const bool last = (t == nt - 2);
            const char* a1 = cA + (size_t)(t + 1) * kstep;
            const char* a2 = last ? nA : cA + (size_t)(t + 2) * kstep; const char* b2 = last ? nB : cB + (size_t)(t + 2) * kstep;
            const char* a3 = a2 + kstep; const char* b3 = b2 + kstep;
            if (last && has_next) S.a_ready(nxt);
            if constexpr (SP2) {
            PG8_LDB(B0, 0, 0); PG8_LDB(B1, 0, 1); PG8_SCHED; PG8_LDA(At, 0, 0); PG8_STAGE(PG8_SA(1, 1), a1 + hstepA, voffA);
            PG8_WAIT_V(8); PG8_WAIT_L(0); PG8_BAR; PG8_MMA(0, 0, At, B0); PG8_MMA(0, 1, At, B1); PG8_BAR; PG8_SCHED;
            PG8_LDA(At, 0, 1); PG8_STAGE(PG8_SB(0, 0), b2, voffB); PG8_STAGE(PG8_SB(0, 1), b2 + hstep, voffB); PG8_STAGE(PG8_SA(0, 0), a2, voffA);
            PG8_WAIT_V(8); PG8_WAIT_L(0); PG8_BAR; PG8_MMA(1, 0, At, B0); PG8_MMA(1, 1, At, B1); PG8_BAR; PG8_SCHED;
            PG8_LDB(B0, 1, 0); PG8_LDB(B1, 1, 1); PG8_SCHED; PG8_LDA(At, 1, 0); PG8_STAGE(PG8_SA(0, 1), a2 + hstepA, voffA);
            PG8_WAIT_V(8); PG8_WAIT_L(0); PG8_BAR; PG8_MMA(0, 0, At, B0); PG8_MMA(0, 1, At, B1); PG8_BAR; PG8_SCHED;
            PG8_LDA(At, 1, 1); PG8_STAGE(PG8_SB(1, 0), b3, voffB); PG8_STAGE(PG8_SB(1, 1), b3 + hstep, voffB); PG8_STAGE(PG8_SA(1, 0), a3, voffA);
            PG8_WAIT_V(8); PG8_WAIT_L(0); PG8_BAR; PG8_MMA(1, 0, At, B0); PG8_MMA(1, 1, At, B1); PG8_BAR; PG8_SCHED;
            } else {
            PG8_LDB(B0, 0, 0); PG8_SCHED; PG8_LDA(At, 0, 0); PG8_STAGE(PG8_SA(1, 1), a1 + hstepA, voffA);
            PG8_WAIT_L(8); PG8_BAR; PG8_WAIT_L(0); PG8_MMA(0, 0, At, B0); PG8_BAR; PG8_SCHED;
            PG8_LDB(B1, 0, 1); PG8_STAGE(PG8_SB(0, 0), b2, voffB);
            PG8_BAR; PG8_WAIT_L(0); PG8_MMA(0, 1, At, B1); PG8_BAR;
            PG8_LDA(At, 0, 1); PG8_STAGE(PG8_SA(0, 0), a2, voffA);
            PG8_BAR; PG8_WAIT_L(0); PG8_MMA(1, 0, At, B0); PG8_BAR; PG8_SCHED;
            PG8_STAGE(PG8_SB(0, 1), b2 + hstep, voffB);
            PG8_WAIT_V(6); PG8_BAR; PG8_MMA(1, 1, At, B1); PG8_BAR;
            PG8_LDB(B0, 1, 0); PG8_SCHED; PG8_LDA(At, 1, 0); PG8_STAGE(PG8_SA(0, 1), a2 + hstepA, voffA);
            PG8_WAIT_L(8); PG8_BAR; PG8_WAIT_L(0); PG8_MMA(0, 0, At, B0); PG8_BAR; PG8_SCHED;
            PG8_LDB(B1, 1, 1); PG8_STAGE(PG8_SB(1, 0), b3, voffB);
            PG8_BAR; PG8_WAIT_L(0); PG8_MMA(0, 1, At, B1); PG8_BAR;
            PG8_LDA(At, 1, 1); PG8_STAGE(PG8_SA(1, 0), a3, voffA);
            PG8_BAR; PG8_WAIT_L(0); PG8_MMA(1, 0, At, B0); PG8_BAR; PG8_SCHED;
            PG8_STAGE(PG8_SB(1, 1), b3 + hstep, voffB);
            PG8_WAIT_V(6); PG8_BAR; PG8_MMA(1, 1, At, B1); PG8_BAR;
            }
        }
        if constexpr (ALIGN_EPI) { if (wr == 0) PG8_BAR; }
        if constexpr (!Epi::AFTER_DRAIN) { E(acc, cur, wr, wc, fr, fq); S.done(cur); }
        if (!has_next) break;
#pragma unroll
        for (int a = 0; a < 2; ++a)
#pragma unroll
            for (int b = 0; b < 2; ++b)
#pragma unroll
                for (int m = 0; m < 4; ++m)
#pragma unroll
                    for (int n = 0; n < 2; ++n) acc[a][b][m][n] = (f32x4){0.f, 0.f, 0.f, 0.f};
        cur = nxt; cA = nA; cB = nB; ++ui;
        if constexpr (ALIGN_EPI) { if (wr == 1) PG8_BAR; }
    }
    PG8_WAIT_V(0);
    if constexpr (!ALIGN_EPI) { if (wr == 0) PG8_BAR; }
    PG8_BAR;
    if constexpr (Epi::AFTER_DRAIN) { E.fused(acc, cur, wr, wc, fr, fq, lds, wid, lane); S.done(cur); }
#undef PG8_SA
#undef PG8_SB
#undef PG8_STAGE
#undef PG8_LDA
#undef PG8_LDB
#undef PG8_MMA
#undef PG8_WAIT_V
#undef PG8_WAIT_L
#undef PG8_BAR
#undef PG8_SCHED
}
}
#ifndef MK_N_LAUNCHES
#define MK_N_LAUNCHES 1
#endif
constexpr int N_PHASES = 7;
constexpr int NWAVES = 8;
constexpr int M = 32768, D = 1024, FF = 4096, NPROJ = 1536, T = 4096;
constexpr size_t MiB = 1u << 20;
constexpr size_t WS_WIN = 0, WS_WOUT = 4 * MiB, WS_WUP = 6 * MiB, WS_WDOWN = 14 * MiB, WS_WPOOL = 22 * MiB, WS_SSQ = 23 * MiB;
constexpr size_t WS_X1B = 32 * MiB, WS_H = 96 * MiB, WS_XN = 96 * MiB, WS_PROJ = 160 * MiB, WS_VT = 256 * MiB, WS_CAT = 288 * MiB, WS_Y = 360 * MiB, WS_END = 424 * MiB;
constexpr int LDS_MISC = 149504, LDS_BYTES = 149504 + 64;
constexpr size_t WS_CTL = 26 * MiB, CTL_BYTES = 16384, WS_RSTD = 30 * MiB;
#define LAS __attribute__((address_space(3)))
typedef unsigned short bf16_t;
typedef short bf16x8 __attribute__((ext_vector_type(8)));
typedef float f32x4 __attribute__((ext_vector_type(4)));
typedef unsigned u32x4 __attribute__((ext_vector_type(4)));
typedef unsigned u32x2 __attribute__((ext_vector_type(2)));
#define LDS_WAIT() asm volatile("s_waitcnt lgkmcnt(0)" ::: "memory")
using pg8::cvt_pk_bf16;
__device__ __forceinline__ float wave_sum(float v) {
#pragma unroll
    for (int o = 1; o < 64; o <<= 1) v += __shfl_xor(v, o);
    return v;
}
__device__ __forceinline__ float bf_lo(unsigned w) { return __builtin_bit_cast(float, w << 16); }
__device__ __forceinline__ float bf_hi(unsigned w) { return __builtin_bit_cast(float, w & 0xffff0000u); }

__device__ __forceinline__ void p0_transpose_item(const float* W, int K, int N, bf16_t* WT, const float* kscale, const float* nscale, LAS float* scr, int item, int lane) {
    const int nblk = N / 32, kb = item / nblk, nb = item % nblk, k0 = 64 * kb, n0 = 32 * nb;
    const float ns = nscale ? nscale[n0 + (lane & 31)] : 1.f;
#pragma unroll 8
    for (int i = 0; i < 32; ++i) { const int kk = 2 * i + (lane >> 5); float w = W[(size_t)(k0 + kk) * N + n0 + (lane & 31)]; if (kscale) w *= kscale[k0 + kk]; scr[kk * 33 + (lane & 31)] = w * ns; }
    LDS_WAIT(); asm volatile("" ::: "memory");
    const int c = lane & 7;
#pragma unroll
    for (int j = 0; j < 4; ++j) { const int n = (lane >> 3) + 8 * j; const LAS float* s = scr + (8 * c) * 33 + n;
        u32x4 o; o.x = cvt_pk_bf16(s[0 * 33], s[1 * 33]); o.y = cvt_pk_bf16(s[2 * 33], s[3 * 33]); o.z = cvt_pk_bf16(s[4 * 33], s[5 * 33]); o.w = cvt_pk_bf16(s[6 * 33], s[7 * 33]);
        *(u32x4*)(WT + (size_t)(n0 + n) * K + k0 + 8 * c) = o; }
    LDS_WAIT(); asm volatile("" ::: "memory");
}

struct Args { const float* in[11]; float* out; unsigned char* ws; int lo, hi; };

constexpr float LOG2E = 1.4426950408889634f;
constexpr int A_K = 0, A_V = 73728, A_TBL = 147456;
#define ATT_BAR() do { asm volatile("s_waitcnt lgkmcnt(0)" ::: "memory"); __builtin_amdgcn_s_barrier(); asm volatile("" ::: "memory"); } while (0)
#define ATT_GLDS(gp, ldsoff) __builtin_amdgcn_global_load_lds((const unsigned*)(gp), (LAS unsigned*)(lds + (ldsoff)), 16, 0, 0)
__device__ __forceinline__ void attn_phase(LAS unsigned char* lds, const bf16_t* __restrict__ PROJ, const bf16_t* __restrict__ KIMG, const bf16_t* __restrict__ VIMG, bf16_t* __restrict__ CAT, const float* __restrict__ rpb,
                                           int vcu, int G, int tid, int lane, int wave, bool first_dma_issued) {
    const int qi = lane & 15, g = lane >> 4, rr = wave >> 2, j = wave & 3;
    const int bs = (j == 0) ? 0 : ((j == 3) ? 32 : 16 * j - 8);
    const int qcol = 16 * j + qi, qc0 = min(max(qcol - 8, 0), 48);
    int idx[8];
#pragma unroll
    for (int jj = 0; jj < 8; ++jj) { const int kc = bs + 8 * g + jj; const bool ok = (kc >= qc0) && (kc < qc0 + 16); idx[jj] = ok ? (kc - qcol + 15) : 31; }
    unsigned koff[2][2], voff[4];
#pragma unroll
    for (int tt = 0; tt < 2; ++tt)
#pragma unroll
        for (int ks = 0; ks < 2; ++ks) { const int key = bs + 8 * (qi >> 2) + (qi & 3) + 4 * tt; koff[tt][ks] = (unsigned)(key * 128 + (((2 * g + ks) ^ ((key >> 1) & 7)) * 16)); }
#pragma unroll
    for (int nt = 0; nt < 4; ++nt) { const int cb = (bs >> 3) + g, dh = 32 * (nt >> 1) + 8 * (qi >> 2) + 4 * (nt & 1) + (qi & 3); voff[nt] = (unsigned)(cb * 1024 + ((dh ^ (4 * (cb & 1))) * 16)); }
    LAS float* tbl = (LAS float*)(lds + A_TBL);
    const unsigned dmaoff = (unsigned)wave * 1024u;
    for (int wu = vcu; wu < 256; wu += G) {
        const int bh = wu >> 2, s0 = (wu & 3) * 8, b = bh >> 3, h = bh & 7;
        const char* kimg = (const char*)KIMG + (size_t)bh * (64 * 8192) + tid * 16;
        const char* vimg = (const char*)VIMG + (size_t)bh * (64 * 8192) + tid * 16;
        const bf16_t* qbase = PROJ + ((size_t)b * T + qcol) * NPROJ + 512 + h * 64 + 16 * g;
        if (!(first_dma_issued && wu == vcu)) ATT_BAR();
        { const int row = tid >> 5, c = tid & 31; tbl[tid] = (row < 15 && c < 31) ? rpb[(h * 15 + row) * 31 + c] * LOG2E : -INFINITY; }
        int krlo = min(max(2 * s0 - 4, 0), 55);
        if (!(first_dma_issued && wu == vcu)) {
#pragma unroll
        for (int ii = 0; ii < 9; ++ii) { const int row = krlo + ii, slot = row % 9; ATT_GLDS(kimg + (size_t)row * 8192, A_K + slot * 8192 + dmaoff); ATT_GLDS(vimg + (size_t)row * 8192, A_V + slot * 8192 + dmaoff); }
        }
        bf16x8 qf0, qf1;
        { const bf16_t* qp = qbase + (size_t)((2 * s0 + rr) * 64) * NPROJ; qf0 = *(const bf16x8*)qp; qf1 = *(const bf16x8*)(qp + 8); }
        unsigned bpk[9][4]; int bkey = -1000;
        asm volatile("s_waitcnt vmcnt(0)" ::: "memory");
        asm volatile("" : "+v"(qf0), "+v"(qf1));
        ATT_BAR();
        for (int st = 0; st < 8; ++st) {
            const int s = s0 + st, r = 2 * s + rr, r0 = min(max(r - 4, 0), 56);
            int sl0 = krlo % 9;
            { const int key = (krlo - r) * 64 + (r0 - r);
              if (key != bkey) { bkey = key;
#pragma unroll
                for (int ii = 0; ii < 9; ++ii) { const int kr = krlo + ii; const int trow = ((kr >= r0) && (kr <= r0 + 7)) ? (kr - r + 7) : 15; const LAS float* tp = tbl + trow * 32;
#pragma unroll
                    for (int pp = 0; pp < 4; ++pp) bpk[ii][pp] = pg8::cvt_pk_bf16(tp[idx[2 * pp]], tp[idx[2 * pp + 1]]); } } }
            f32x4 sc[9][2];
            { int sl = sl0;
              bf16x8 kb[2][2][2];
#define ATT_LOADK(ii_, buf_) do { const unsigned base_ = (unsigned)(A_K + sl * 8192); \
                _Pragma("unroll") for (int tt = 0; tt < 2; ++tt) { kb[buf_][tt][0] = *(const LAS bf16x8*)(lds + base_ + koff[tt][0]); kb[buf_][tt][1] = *(const LAS bf16x8*)(lds + base_ + koff[tt][1]); } \
                sl = (sl == 8) ? 0 : sl + 1; } while (0)
              ATT_LOADK(0, 0);
#pragma unroll
              for (int ii = 0; ii < 9; ++ii) {
                if (ii < 8) ATT_LOADK(ii + 1, (ii + 1) & 1);
                __builtin_amdgcn_sched_barrier(0);
#pragma unroll
                for (int tt = 0; tt < 2; ++tt) { f32x4 a = {bf_lo(bpk[ii][2 * tt]), bf_hi(bpk[ii][2 * tt]), bf_lo(bpk[ii][2 * tt + 1]), bf_hi(bpk[ii][2 * tt + 1])};
                    a = __builtin_amdgcn_mfma_f32_16x16x32_bf16(kb[ii & 1][tt][0], qf0, a, 0, 0, 0);
                    a = __builtin_amdgcn_mfma_f32_16x16x32_bf16(kb[ii & 1][tt][1], qf1, a, 0, 0, 0);
                    sc[ii][tt] = a; }
                __builtin_amdgcn_sched_barrier(0);
              }
#undef ATT_LOADK
            }
            ATT_BAR();
            const int sn = min(s + 1, 31), krn = min(max(2 * sn - 4, 0), 55);
            { const int ra = krn + 7, rb = krn + 8; ATT_GLDS(kimg + (size_t)ra * 8192, A_K + (ra % 9) * 8192 + dmaoff); ATT_GLDS(kimg + (size_t)rb * 8192, A_K + (rb % 9) * 8192 + dmaoff); }
            bf16x8 qn0, qn1;
            { const bf16_t* qp = qbase + (size_t)((2 * sn + rr) * 64) * NPROJ; qn0 = *(const bf16x8*)qp; qn1 = *(const bf16x8*)(qp + 8); }
            float mx = -INFINITY;
#pragma unroll
            for (int ii = 0; ii < 9; ++ii)
#pragma unroll
                for (int jj = 0; jj < 8; ++jj) mx = fmaxf(mx, sc[ii][jj >> 2][jj & 3]);
            mx = fmaxf(mx, __shfl_xor(mx, 16)); mx = fmaxf(mx, __shfl_xor(mx, 32));
            float sum = 0.f;
            bf16x8 pf[9];
#pragma unroll
            for (int ii = 0; ii < 9; ++ii) {
#pragma unroll
                for (int jj = 0; jj < 8; ++jj) { const float p = __builtin_amdgcn_exp2f(sc[ii][jj >> 2][jj & 3] - mx); sc[ii][jj >> 2][jj & 3] = p; sum += p; }
                const u32x4 w = pg8::pack8(sc[ii][0], sc[ii][1]); pf[ii] = __builtin_bit_cast(bf16x8, w); }
            sum += __shfl_xor(sum, 16); sum += __shfl_xor(sum, 32);
            const float inv = 1.0f / sum;
            asm volatile("s_waitcnt vmcnt(4)" ::: "memory");
            ATT_BAR();
            f32x4 o[4];
#pragma unroll
            for (int nt = 0; nt < 4; ++nt) o[nt] = (f32x4){0.f, 0.f, 0.f, 0.f};
            { int sl = sl0;
              bf16x8 vb[2][4];
#define ATT_LOADV(buf_) do { const unsigned base_ = (unsigned)(A_V + sl * 8192); _Pragma("unroll") for (int nt = 0; nt < 4; ++nt) vb[buf_][nt] = *(const LAS bf16x8*)(lds + base_ + voff[nt]); sl = (sl == 8) ? 0 : sl + 1; } while (0)
              ATT_LOADV(0);
#pragma unroll
              for (int ii = 0; ii < 9; ++ii) {
                if (ii < 8) ATT_LOADV((ii + 1) & 1);
                __builtin_amdgcn_sched_barrier(0);
#pragma unroll
                for (int nt = 0; nt < 4; ++nt) o[nt] = __builtin_amdgcn_mfma_f32_16x16x32_bf16(vb[ii & 1][nt], pf[ii], o[nt], 0, 0, 0);
                __builtin_amdgcn_sched_barrier(0);
              }
#undef ATT_LOADV
            }
            ATT_BAR();
            asm volatile("s_waitcnt vmcnt(0)" ::: "memory");
            asm volatile("" : "+v"(qn0), "+v"(qn1));
            qf0 = qn0; qf1 = qn1;
            { const int ra = krn + 7, rb = krn + 8; ATT_GLDS(vimg + (size_t)ra * 8192, A_V + (ra % 9) * 8192 + dmaoff); ATT_GLDS(vimg + (size_t)rb * 8192, A_V + (rb % 9) * 8192 + dmaoff); }
            bf16_t* op = CAT + ((size_t)b * T + r * 64 + qcol) * 1024 + 512 + h * 64 + 8 * g;
            *(u32x4*)op = pg8::pack8(o[0] * inv, o[1] * inv);
            *(u32x4*)(op + 32) = pg8::pack8(o[2] * inv, o[3] * inv);
            ATT_BAR();
            krlo = krn;
        }
        asm volatile("s_waitcnt vmcnt(0)" ::: "memory");
    }
    ATT_BAR();
}

__device__ __forceinline__ void pool_wave_group(const bf16_t* __restrict__ PROJ, const bf16_t* __restrict__ WPT, bf16_t* __restrict__ CAT, int gi, int tile_first, int tile_step, int lane) {
    const int qi = lane & 15, g = lane >> 4;
    const int w = 2 << gi, half = w >> 1;
    const unsigned ulane = (unsigned)((8 * (qi >> 2) + (qi & 3)) * NPROJ + 8 * g) * 2u;
    const char* wbase = (const char*)(WPT + (size_t)gi * 16384);
    const unsigned wlane = (unsigned)((8 * (qi >> 2) + (qi & 3)) * 128 + 8 * g) * 2u;
    bf16x8 wf[4][2][4];
#pragma unroll
    for (int np = 0; np < 4; ++np)
#pragma unroll
        for (int e = 0; e < 2; ++e)
#pragma unroll
            for (int ks = 0; ks < 4; ++ks) wf[np][e][ks] = *(const bf16x8*)(wbase + ((32 * np + 4 * e) * 128 + 32 * ks) * 2 + wlane);
    bf16x8 ua[4], ub[4];
    if (tile_first < M / 16) {
        const char* ubase = (const char*)(PROJ + ((long)tile_first * 16 - 8) * NPROJ + gi * 128);
#pragma unroll
        for (int ks = 0; ks < 4; ++ks) { ua[ks] = *(const bf16x8*)(ubase + ks * 64 + ulane); ub[ks] = *(const bf16x8*)(ubase + 4 * NPROJ * 2 + ks * 64 + ulane); }
    }
    for (int tile16 = tile_first; tile16 < M / 16; tile16 += tile_step) {
        bf16x8 ca[4], cb[4];
#pragma unroll
        for (int ks = 0; ks < 4; ++ks) { ca[ks] = ua[ks]; cb[ks] = ub[ks]; }
        { const int tn = (tile16 + tile_step < M / 16) ? tile16 + tile_step : tile16;
          const char* ubase = (const char*)(PROJ + ((long)tn * 16 - 8) * NPROJ + gi * 128);
#pragma unroll
          for (int ks = 0; ks < 4; ++ks) { ua[ks] = *(const bf16x8*)(ubase + ks * 64 + ulane); ub[ks] = *(const bf16x8*)(ubase + 4 * NPROJ * 2 + ks * 64 + ulane); } }
        const int t0 = (tile16 * 16) & (T - 1);
        const int tq = t0 + qi, lo = max(tq - half, 0), hi = min(tq - half + w, T);
        const float invn = 1.0f / (float)(hi - lo);
        float pv[8];
#pragma unroll
        for (int jj = 0; jj < 8; ++jj) { const int tp = t0 - 8 + 8 * g + jj; pv[jj] = ((tp >= lo && tp < hi) ? invn : 0.f) - ((tp == tq) ? 1.f : 0.f); }
        const u32x4 pmw = pg8::pack8((f32x4){pv[0], pv[1], pv[2], pv[3]}, (f32x4){pv[4], pv[5], pv[6], pv[7]});
        const bf16x8 pm = __builtin_bit_cast(bf16x8, pmw);
        __builtin_amdgcn_sched_barrier(0);
        bf16_t* op = CAT + ((size_t)tile16 * 16 + qi) * 1024 + gi * 128 + 8 * g;
#pragma unroll
        for (int np = 0; np < 4; ++np) {
            f32x4 c[2];
#pragma unroll
            for (int e = 0; e < 2; ++e) {
                f32x4 za = {0.f, 0.f, 0.f, 0.f}, zb = {0.f, 0.f, 0.f, 0.f};
#pragma unroll
                for (int ks = 0; ks < 4; ++ks) { za = __builtin_amdgcn_mfma_f32_16x16x32_bf16(ca[ks], wf[np][e][ks], za, 0, 0, 0); zb = __builtin_amdgcn_mfma_f32_16x16x32_bf16(cb[ks], wf[np][e][ks], zb, 0, 0, 0); }
                const u32x4 zw = pg8::pack8(za, zb);
                c[e] = __builtin_amdgcn_mfma_f32_16x16x32_bf16(__builtin_bit_cast(bf16x8, zw), pm, (f32x4){0.f, 0.f, 0.f, 0.f}, 0, 0, 0);
            }
            *(u32x4*)(op + 32 * np) = pg8::pack8(c[0], c[1]);
        }
    }
}

typedef __attribute__((address_space(1))) unsigned gu32;
#define RLX_AGENT __ATOMIC_RELAXED, __HIP_MEMORY_SCOPE_AGENT
#define XB_TMO      128
#define XB_XCNT(j)  (256  + 64 * (j))
#define XB_XSUB(j)  (1280 + 64 * (j))
#define XB_XGEN(j)  (2304 + 64 * (j))
#define XB_TOP      3328
#define XB_TOPGEN   3392
#define XCD_BAR_WORDS 3456
#define XB_SPIN_CAP (1u << 18)

__device__ __forceinline__ unsigned xb_ld(unsigned* p)              { return __hip_atomic_load(p, __ATOMIC_RELAXED, __HIP_MEMORY_SCOPE_AGENT); }
__device__ __forceinline__ unsigned xb_add(unsigned* p, unsigned v) { return __hip_atomic_fetch_add(p, v, __ATOMIC_RELAXED, __HIP_MEMORY_SCOPE_AGENT); }
__device__ __forceinline__ unsigned xb_xcc_id() { return (unsigned)__builtin_amdgcn_s_getreg((3 << 11) | 20) & 0xFu; }
#define XB_SPIN(cond, bar) do { unsigned _sp = 0; while (cond) { __builtin_amdgcn_s_sleep(1); \
    if ((++_sp & 255u) == 0u) { if (xb_ld(&(bar)[XB_TMO])) break; if (_sp > XB_SPIN_CAP) { atomicAdd(&(bar)[XB_TMO], 1u); break; } } } } while (0)

struct XcdBarrier {
    unsigned* bar; unsigned x;
    volatile LAS unsigned* st;
};

__device__ __forceinline__ XcdBarrier xcd_barrier_post(unsigned* bar, volatile LAS unsigned* st) {
    XcdBarrier b; b.bar = bar; b.x = xb_xcc_id(); b.st = st;
    if (threadIdx.x == 0) (void)xb_add(&bar[XB_XCNT(b.x)], 1u);
    return b;
}
__device__ __forceinline__ void xcd_barrier_complete(unsigned* bar, unsigned x, unsigned& nloc, unsigned& nx) {
    const unsigned G = gridDim.x * gridDim.y * gridDim.z;
    unsigned sum, cnt, mine, sp = 0u;
    for (;;) {
        sum = 0u; cnt = 0u; mine = 0u;
#pragma unroll
        for (unsigned j = 0; j < 16; ++j) { const unsigned c = xb_ld(&bar[XB_XCNT(j)]); sum += c; cnt += (c > 0u) ? 1u : 0u; mine = (j == x) ? c : mine; }
        if (sum == G) break;
        __builtin_amdgcn_s_sleep(1);
        if ((++sp & 255u) == 0u) { if (xb_ld(&bar[XB_TMO])) break; if (sp > XB_SPIN_CAP) { atomicAdd(&bar[XB_TMO], 1u); break; } }
    }
    nloc = mine > 0u ? mine : 1u; nx = cnt > 0u ? cnt : 1u;
}

__device__ __forceinline__ void xcd_barrier(const XcdBarrier& b) {
    asm volatile("s_waitcnt vmcnt(0)" ::: "memory");
    __syncthreads();
    if (threadIdx.x == 0) {
        unsigned* bar = b.bar;
        __builtin_amdgcn_s_waitcnt(0);
        unsigned nloc = b.st[0], nx = b.st[1];
        if (nloc == 0u) { xcd_barrier_complete(bar, b.x, nloc, nx); b.st[0] = nloc; b.st[1] = nx; }
        const unsigned old = xb_add(&bar[XB_XSUB(b.x)], 1u);
        const unsigned gen = old / nloc;
        if (old + 1u == (gen + 1u) * nloc) {
            __builtin_amdgcn_fence(__ATOMIC_RELEASE, "agent");
            asm volatile("s_waitcnt vmcnt(0)" ::: "memory");
            const unsigned og = xb_add(&bar[XB_TOP], 1u);
            const unsigned tg = og / nx;
            if (og + 1u == (tg + 1u) * nx) xb_add(&bar[XB_TOPGEN], 1u);
            else XB_SPIN(xb_ld(&bar[XB_TOPGEN]) == tg, bar);
            __builtin_amdgcn_fence(__ATOMIC_ACQUIRE, "agent");
            xb_add(&bar[XB_XGEN(b.x)], 1u);
            asm volatile("s_waitcnt vmcnt(0)" ::: "memory");
        } else {
            XB_SPIN(xb_ld(&bar[XB_XGEN(b.x)]) == gen, bar);
            __builtin_amdgcn_fence(__ATOMIC_ACQUIRE, "agent");
            asm volatile("s_waitcnt vmcnt(0)" ::: "memory");
        }
    }
    __syncthreads();
}

__global__ void __launch_bounds__(NWAVES * 64, 2) mk_fwd(Args args) {
    extern __shared__ __attribute__((aligned(16))) unsigned char lds_raw[];
    LAS unsigned char* lds = (LAS unsigned char*)lds_raw;
    const int tid = threadIdx.x, lane = tid & 63, wave = __builtin_amdgcn_readfirstlane(tid >> 6);
    const int G = gridDim.x, bx = blockIdx.x;
    const int vcu = (G % 8 == 0) ? (bx % 8) * (G / 8) + bx / 8 : bx;
    const int gw = vcu * NWAVES + wave, NGW = G * NWAVES;
    unsigned char* ws = args.ws;
    const float* x = args.in[0]; const float* g1 = args.in[1]; const float* w_in = args.in[2]; const float* w_pool = args.in[3]; const float* pool_scale = args.in[4];
    const float* rpb = args.in[5]; const float* w_out = args.in[6]; const float* g2 = args.in[7]; const float* w_up = args.in[8]; const float* w_down = args.in[9]; const float* gf = args.in[10];
    float* out = args.out;
    bf16_t* WIN_T = (bf16_t*)(ws + WS_WIN); bf16_t* WOUT_T = (bf16_t*)(ws + WS_WOUT); bf16_t* WUP_T = (bf16_t*)(ws + WS_WUP); bf16_t* WDOWN_T = (bf16_t*)(ws + WS_WDOWN); bf16_t* WPOOL_T = (bf16_t*)(ws + WS_WPOOL);
    float* SSQ = (float*)(ws + WS_SSQ); float* RSTD1 = (float*)(ws + WS_RSTD);
    bf16_t* X1B = (bf16_t*)(ws + WS_X1B); bf16_t* HB = (bf16_t*)(ws + WS_H); bf16_t* XN = (bf16_t*)(ws + WS_XN); bf16_t* PROJ = (bf16_t*)(ws + WS_PROJ); bf16_t* VT = (bf16_t*)(ws + WS_VT); bf16_t* KIMG = (bf16_t*)(ws + WS_X1B); bf16_t* CAT = (bf16_t*)(ws + WS_CAT);
    const int lo = args.lo, hi = args.hi;
#define IN(k) (lo <= (k) && (k) < hi)
#ifndef DUP_PHASE
#define DUP_PHASE -1
#endif
#define REP(k) for (int rep_ = 0; rep_ < ((k) == DUP_PHASE ? 2 : 1); ++rep_)
#define SEAM(k) do { if (IN(k) && IN((k) + 1)) xcd_barrier(bar); } while (0)
    volatile LAS unsigned* misc = (volatile LAS unsigned*)(lds + LDS_MISC);
    if (tid < 16) misc[tid] = 0u;
    __syncthreads();
    XcdBarrier bar; bar.bar = (unsigned*)(ws + WS_CTL); bar.x = 0; bar.st = nullptr;
    if (hi - lo > 1) bar = xcd_barrier_post((unsigned*)(ws + WS_CTL), misc);
    if (lo > N_PHASES) cg::this_grid().sync();

    if (IN(0)) REP(0) {
        LAS float* scr = (LAS float*)(lds + wave * 16384);
        constexpr int I_IN = (D / 64) * (2048 / 32), I_OUT = (D / 64) * (D / 32), I_UP = (D / 64) * (FF / 32), I_DN = (FF / 64) * (D / 32), I_PL = 2 * 4;
        constexpr int NITEMS = I_IN + I_OUT + I_UP + I_DN + 4 * I_PL;
        f32x4 gv[4];
#pragma unroll
        for (int j = 0; j < 4; ++j) gv[j] = ((const f32x4*)g1)[lane + 64 * j];
        for (int pass = 0; pass < 2; ++pass) {
        if (((wave & 1) == 0) == (pass == 0)) {
        for (int it = gw; it < NITEMS; it += NGW) {
            int r = it;
            if (r < I_IN) { p0_transpose_item(w_in, D, 2048, WIN_T, nullptr, nullptr, scr, r, lane); continue; } r -= I_IN;
            if (r < I_OUT) { p0_transpose_item(w_out, D, D, WOUT_T, nullptr, nullptr, scr, r, lane); continue; } r -= I_OUT;
            if (r < I_UP) { p0_transpose_item(w_up, D, FF, WUP_T, g2, nullptr, scr, r, lane); continue; } r -= I_UP;
            if (r < I_DN) { p0_transpose_item(w_down, FF, D, WDOWN_T, nullptr, nullptr, scr, r, lane); continue; } r -= I_DN;
            const int gi = r / I_PL; r -= gi * I_PL;
            p0_transpose_item(w_pool + (size_t)gi * 16384, 128, 128, WPOOL_T + (size_t)gi * 16384, nullptr, pool_scale + gi * 128, scr, r, lane);
        }
        } else {
        for (int m = gw; m < M; m += NGW) {
            const f32x4* xr = (const f32x4*)(x + (size_t)m * D) + lane; f32x4 v[4]; float s = 0.f;
#pragma unroll
            for (int j = 0; j < 4; ++j) { v[j] = xr[64 * j]; s += (v[j].x * v[j].x + v[j].y * v[j].y) + (v[j].z * v[j].z + v[j].w * v[j].w); }
            const float rstd = __builtin_amdgcn_rsqf(wave_sum(s) * (1.f / D) + 1e-6f);
            if (lane == 0) RSTD1[m] = rstd;
            u32x2* o8 = (u32x2*)(XN + (size_t)m * D) + lane;
#pragma unroll
            for (int j = 0; j < 4; ++j) { const f32x4 y = v[j] * rstd * gv[j]; u32x2 w; w.x = cvt_pk_bf16(y.x, y.y); w.y = cvt_pk_bf16(y.z, y.w); o8[64 * j] = w; }
        }
        } }
    }
    SEAM(0);
    if (IN(1)) REP(1) {
        { pg8::Gemm g{XN, WIN_T, M, NPROJ, D, D}; pg8::StaticOrder S; S.init(M, NPROJ, G, bx); pg8::EpiProj E{PROJ, NPROJ, KIMG};
          pg8::gemm_phase<pg8::EpiProj, pg8::StaticOrder, true, true>(lds, g, S, E); }
        { pg8::Gemm g{XN, WIN_T + (size_t)NPROJ * D, M, 512, D, D}; pg8::StaticOrder S; S.init(M, 512, G, bx); pg8::EpiVT E{VT};
          pg8::gemm_phase<pg8::EpiVT, pg8::StaticOrder, true, true>(lds, g, S, E); }
    }
    SEAM(1);
    if (IN(2)) REP(2) {
        const bool pre = (vcu < 256);
        if (pre) {
            const int bh = vcu >> 2, s0 = (vcu & 3) * 8, krlo = min(max(2 * s0 - 4, 0), 55);
            const char* kimg = (const char*)KIMG + (size_t)bh * (64 * 8192) + tid * 16; const char* vimg = (const char*)VT + (size_t)bh * (64 * 8192) + tid * 16;
            ATT_BAR();
#pragma unroll
            for (int ii = 0; ii < 9; ++ii) { const int row = krlo + ii, slot = row % 9; ATT_GLDS(kimg + (size_t)row * 8192, A_K + slot * 8192 + wave * 1024); ATT_GLDS(vimg + (size_t)row * 8192, A_V + slot * 8192 + wave * 1024); }
        }
        pool_wave_group(PROJ, WPOOL_T, CAT, wave & 3, vcu * 2 + (wave >> 2), G * 2, lane);
        attn_phase(lds, PROJ, KIMG, VT, CAT, rpb, vcu, G, tid, lane, wave, pre);
        __syncthreads();
    }
    SEAM(2);
    if (IN(3)) REP(3) {
        pg8::Gemm g{CAT, WOUT_T, M, D, D, D}; pg8::StaticOrder S; S.init(M, D, G, bx);
        LAS float* rt3 = (LAS float*)(lds + 131072); LAS float* gt3 = rt3 + 512;
        pg8::Unit ua, ub; const bool two = (G == 256) && S.next(0, ua) && S.next(1, ub);
        int gok = 1;
        if (two) { rt3[tid] = 1.0f / RSTD1[((tid < 256) ? ua.pm : ub.pm) * 256 + (tid & 255)];
            const float ga = g1[tid], gb = g1[tid + 512]; gt3[tid] = 1.0f / ga; gt3[tid + 512] = 1.0f / gb; gok = (fabsf(ga) > 1e-3f) && (fabsf(gb) > 1e-3f); }
        gok = __syncthreads_and(gok);
        if (two && gok) { pg8::EpiRes1N E{XN, X1B, SSQ, rt3, gt3, ua.pm}; pg8::gemm_phase<pg8::EpiRes1N, pg8::StaticOrder, true, true>(lds, g, S, E); }
        else { pg8::EpiRes1 E{x, X1B, SSQ}; pg8::gemm_phase<pg8::EpiRes1, pg8::StaticOrder, true, true>(lds, g, S, E); }
    }
    SEAM(3);
    if (IN(4)) REP(4) {
        pg8::Gemm g{X1B, WUP_T, M, FF, D, D}; pg8::StaticOrder S; S.init(M, FF, G, bx);
        pg8::Unit ua, ub; const bool two = (G == 256) && S.next(0, ua) && S.next(4, ub);
        LAS float* rl = (LAS float*)(lds + 131072);
        if (two) { const int row = ((tid < 256) ? ua.pm : ub.pm) * 256 + (tid & 255); const f32x4* sp = (const f32x4*)(SSQ + (size_t)row * 16);
            const f32x4 p = (sp[0] + sp[1]) + (sp[2] + sp[3]); rl[tid] = __builtin_amdgcn_rsqf(((p[0] + p[1]) + (p[2] + p[3])) * (1.0f / 1024.0f) + 1e-6f); }
        __syncthreads();
        pg8::EpiUp E{HB, SSQ, rl, two ? ua.pm : -1};
        pg8::gemm_phase<pg8::EpiUp, pg8::StaticOrder, true, true>(lds, g, S, E);
    }
    SEAM(4);
    if (IN(5)) REP(5) {
        pg8::Gemm g{HB, WDOWN_T, M, D, FF, pg8::EpiUp::HP}; pg8::StaticOrder S; S.init(M, D, G, bx); pg8::EpiY E{(bf16_t*)(ws + WS_Y)};
        pg8::gemm_phase<pg8::EpiY, pg8::StaticOrder, true, true>(lds, g, S, E);
    }
    SEAM(5);
    if (IN(6)) {
        const bf16_t* YB = (const bf16_t*)(ws + WS_Y);
        f32x4 gv[4];
#pragma unroll
        for (int j = 0; j < 2; ++j) { gv[2 * j] = ((const f32x4*)gf)[2 * lane + 128 * j]; gv[2 * j + 1] = ((const f32x4*)gf)[2 * lane + 128 * j + 1]; }
        for (int m0 = 2 * gw; m0 < M; m0 += 2 * NGW) {
            u32x4 wq[2][4];
#pragma unroll
            for (int q = 0; q < 2; ++q) { const int m = min(m0 + q, M - 1); const u32x4* xr = (const u32x4*)(X1B + (size_t)m * D) + lane; const u32x4* yr = (const u32x4*)(YB + (size_t)m * D) + lane;
                wq[q][0] = xr[0]; wq[q][1] = xr[64]; wq[q][2] = yr[0]; wq[q][3] = yr[64]; }
#pragma unroll
            for (int q = 0; q < 2; ++q) { const int m = m0 + q; if (m >= M) continue;
                const u32x4 w0 = wq[q][0], w1 = wq[q][1], y0 = wq[q][2], y1 = wq[q][3];
                const f32x4 a0 = (f32x4){bf_lo(w0.x), bf_hi(w0.x), bf_lo(w0.y), bf_hi(w0.y)} + (f32x4){bf_lo(y0.x), bf_hi(y0.x), bf_lo(y0.y), bf_hi(y0.y)};
                const f32x4 a1 = (f32x4){bf_lo(w0.z), bf_hi(w0.z), bf_lo(w0.w), bf_hi(w0.w)} + (f32x4){bf_lo(y0.z), bf_hi(y0.z), bf_lo(y0.w), bf_hi(y0.w)};
                const f32x4 a2 = (f32x4){bf_lo(w1.x), bf_hi(w1.x), bf_lo(w1.y), bf_hi(w1.y)} + (f32x4){bf_lo(y1.x), bf_hi(y1.x), bf_lo(y1.y), bf_hi(y1.y)};
                const f32x4 a3 = (f32x4){bf_lo(w1.z), bf_hi(w1.z), bf_lo(w1.w), bf_hi(w1.w)} + (f32x4){bf_lo(y1.z), bf_hi(y1.z), bf_lo(y1.w), bf_hi(y1.w)};
                float s = ((a0.x * a0.x + a0.y * a0.y) + (a0.z * a0.z + a0.w * a0.w)) + ((a1.x * a1.x + a1.y * a1.y) + (a1.z * a1.z + a1.w * a1.w))
                        + ((a2.x * a2.x + a2.y * a2.y) + (a2.z * a2.z + a2.w * a2.w)) + ((a3.x * a3.x + a3.y * a3.y) + (a3.z * a3.z + a3.w * a3.w));
                const float rstd = __builtin_amdgcn_rsqf(wave_sum(s) * (1.f / D) + 1e-6f);
                f32x4* orow = (f32x4*)(out + (size_t)m * D) + 2 * lane;
                orow[0] = a0 * rstd * gv[0]; orow[1] = a1 * rstd * gv[1]; orow[128] = a2 * rstd * gv[2]; orow[129] = a3 * rstd * gv[3]; }
        }
    }
#undef IN
#undef SEAM
}

extern "C" void kernel_launch(void* const* d_in, const int* in_sizes, int n_in, void* d_out, int out_size, void* d_ws, size_t ws_size, hipStream_t stream) {
    static int grid = 0;
    if (grid == 0) {
        if (n_in != 11 || in_sizes[0] != M * D || out_size != M * D || ws_size < WS_END) { fprintf(stderr, "kernel_launch: unexpected shapes (n_in %d, in0 %d, out %d, ws %zu); nothing launched\n", n_in, n_in > 0 ? in_sizes[0] : -1, out_size, ws_size); grid = -1; return; }
        int dev = 0, cus = 0, per_cu = 0;
        if (hipGetDevice(&dev) != hipSuccess || hipDeviceGetAttribute(&cus, hipDeviceAttributeMultiprocessorCount, dev) != hipSuccess) { grid = -1; return; }
        if (hipFuncSetAttribute((const void*)mk_fwd, hipFuncAttributeMaxDynamicSharedMemorySize, LDS_BYTES) != hipSuccess) { fprintf(stderr, "kernel_launch: hipFuncSetAttribute failed\n"); grid = -1; return; }
        if (hipOccupancyMaxActiveBlocksPerMultiprocessor(&per_cu, (const void*)mk_fwd, NWAVES * 64, LDS_BYTES) != hipSuccess || per_cu < 1) { fprintf(stderr, "kernel_launch: occupancy query says %d\n", per_cu); per_cu = 1; }
        (void)hipGetLastError();
        grid = cus * 1;
    }
    if (grid < 0) return;
    Args a{};
    for (int i = 0; i < 11; ++i) a.in[i] = (const float*)d_in[i];
    a.out = (float*)d_out; a.ws = (unsigned char*)d_ws;
#if MK_N_LAUNCHES == 1
    a.lo = 0; a.hi = N_PHASES;
    if (hipMemsetAsync((char*)d_ws + WS_CTL, 0, CTL_BYTES, stream) != hipSuccess) { fprintf(stderr, "kernel_launch: memset of the barrier words failed\n"); return; }
    void* kargs[] = {&a};
    hipError_t e = hipLaunchCooperativeKernel((const void*)mk_fwd, dim3(grid), dim3(NWAVES * 64), kargs, LDS_BYTES, stream);
    if (e != hipSuccess) fprintf(stderr, "kernel_launch: cooperative launch failed: %s (grid %d)\n", hipGetErrorString(e), grid);
#else
    for (int p = 0; p < N_PHASES; ++p) { a.lo = p; a.hi = p + 1; hipLaunchKernelGGL(mk_fwd, dim3(grid), dim3(NWAVES * 64), LDS_BYTES, stream, a); }
#endif
}
```

```cpp
#define MK_N_LAUNCHES 1
#define DUP_PHASE -1
#include <hip/hip_runtime.h>
#include <hip/hip_cooperative_groups.h>
#include <cstdio>
#include <cstdint>
#include <cmath>
namespace cg = cooperative_groups;
namespace pg8 {
#define PG8_LAS __attribute__((address_space(3)))
typedef unsigned short bf16_t;
typedef short bf16x8 __attribute__((ext_vector_type(8)));
typedef float f32x4 __attribute__((ext_vector_type(4)));
typedef unsigned u32x4 __attribute__((ext_vector_type(4)));
constexpr int BM = 256, BK = 64, HALF = 128, HTB = HALF * BK * 2  , STAGE_BYTES = 8 * HTB, NXCD = 8, WGM = 8;

__host__ __device__ __forceinline__ int lds_byte(int r, int c) { const int st = (r >> 4) * 2 + (c >> 5), rr = r & 15, cc = c & 31, ob = rr * 64 + cc * 2; return st * 1024 + (ob ^ (((ob >> 9) & 1) << 5)); }
__host__ __device__ __forceinline__ void stage_rc(int b, int& R, int& C) { const int st = b / 1024, sb = b % 1024, swz = sb ^ (((sb >> 9) & 1) << 5); R = (st >> 1) * 16 + swz / 64; C = (st & 1) * 32 + (swz % 64) / 2; }
__host__ __device__ __forceinline__ int perm32(int rho) { const int n = rho >> 4, i = rho & 15; return 8 * (i >> 2) + 4 * n + (i & 3); }

struct Unit { int pm, pn; };
struct Gemm { const bf16_t* A; const bf16_t* Bt; int M, N, K, lda; };

struct StaticOrder {
    int nM, nN, nwg, G, c;
    __host__ __device__ void init(int M, int N, int G_, int c_) { nM = M / BM; nN = N / BM; nwg = nM * nN; G = G_; c = c_; }
    __host__ __device__ bool next(int i, Unit& u) const {
        const long L = (long)i * G + c; if (L >= nwg) return false;
        int wgid = (int)L; { const int q = nwg / NXCD, r = nwg % NXCD, xcd = wgid % NXCD, off = wgid / NXCD; wgid = (xcd < r ? xcd * (q + 1) : r * (q + 1) + (xcd - r) * q) + off; }
        const int nig = WGM * nN, gid = wgid / nig, fm = gid * WGM, gsz = (nM - fm) < WGM ? (nM - fm) : WGM;
        u.pm = fm + ((wgid % nig) % gsz); u.pn = (wgid % nig) / gsz; return true;
    }
    __device__ __forceinline__ void a_ready(const Unit&) const {}
    __device__ __forceinline__ void done(const Unit&) const {}
};

typedef float f32x2c __attribute__((ext_vector_type(2))); typedef __bf16 bf16x2c __attribute__((ext_vector_type(2)));
__device__ __forceinline__ unsigned cvt_pk_bf16(float lo, float hi) { const f32x2c v = {lo, hi}; const bf16x2c b = __builtin_convertvector(v, bf16x2c); return __builtin_bit_cast(unsigned, b); }
typedef float f32x2 __attribute__((ext_vector_type(2)));
__device__ __forceinline__ float bfl(unsigned w) { return __builtin_bit_cast(float, w << 16); }
__device__ __forceinline__ float bfh(unsigned w) { return __builtin_bit_cast(float, w & 0xffff0000u); }
__device__ __forceinline__ u32x4 pack8(const f32x4 a, const f32x4 b) { u32x4 w; w.x = cvt_pk_bf16(a[0], a[1]); w.y = cvt_pk_bf16(a[2], a[3]); w.z = cvt_pk_bf16(b[0], b[1]); w.w = cvt_pk_bf16(b[2], b[3]); return w; }

struct EpiProj {
    static constexpr bool PERM = true, PERM_A = false, SWAP = false, AFTER_DRAIN = false;
    bf16_t* O; int ldc; bf16_t* KIMG;
    __device__ __forceinline__ void operator()(const f32x4 (&acc)[2][2][4][2], const Unit& u, int wr, int wc, int fr, int fq) const {
        const int row0 = u.pm * BM + wr * 64 + fr, col0 = u.pn * BM + wc * 32 + 8 * fq;
        if (u.pn < 4) {
            const float qs = (u.pn >= 2) ? 0.125f * 1.4426950408889634f : 1.0f;
#pragma unroll
            for (int ai = 0; ai < 2; ++ai)
#pragma unroll
                for (int m = 0; m < 4; ++m) { bf16_t* rowp = O + (size_t)(row0 + ai * HALF + m * 16) * ldc + col0;
#pragma unroll
                    for (int bj = 0; bj < 2; ++bj) *(u32x4*)(rowp + bj * HALF) = pack8(acc[ai][bj][m][0] * qs, acc[ai][bj][m][1] * qs); }
        } else {
            const int slot = (wc & 1) * 4 + fq;
#pragma unroll
            for (int ai = 0; ai < 2; ++ai)
#pragma unroll
                for (int m = 0; m < 4; ++m) { const int tok = row0 + ai * HALF + m * 16, b = tok >> 12, rc = tok & 4095, cg = tok & 63;
#pragma unroll
                    for (int bj = 0; bj < 2; ++bj) { const int h = (u.pn - 4) * 4 + bj * 2 + (wc >> 1);
                        bf16_t* p = KIMG + ((((size_t)(b * 8 + h) * 4096 + rc) * 8 + (slot ^ ((cg >> 1) & 7))) * 8);
                        *(u32x4*)p = pack8(acc[ai][bj][m][0], acc[ai][bj][m][1]); } }
        }
    }
};
struct EpiVT {
    static constexpr bool PERM = false, PERM_A = true, SWAP = true, AFTER_DRAIN = false;
    bf16_t* VIMG;
    __device__ __forceinline__ void operator()(const f32x4 (&acc)[2][2][4][2], const Unit& u, int wr, int wc, int fr, int fq) const {
        const int b = u.pm >> 4, t0 = (u.pm & 15) * 256 + wr * 64 + 8 * fq, c0 = u.pn * BM + wc * 32 + fr;
#pragma unroll
        for (int bj = 0; bj < 2; ++bj)
#pragma unroll
            for (int n = 0; n < 2; ++n) { const int c = c0 + bj * HALF + n * 16, h = c >> 6, dh = c & 63;
#pragma unroll
                for (int ai = 0; ai < 2; ++ai)
#pragma unroll
                    for (int mp = 0; mp < 2; ++mp) { const int t = t0 + ai * HALF + mp * 32, rowcb = t >> 3;
                        bf16_t* p = VIMG + (((size_t)(b * 8 + h) * 512 + rowcb) * 64 + (dh ^ (4 * (rowcb & 1)))) * 8;
                        *(u32x4*)p = pack8(acc[ai][bj][2 * mp][n], acc[ai][bj][2 * mp + 1][n]); } }
    }
};
struct EpiRes1 {
    static constexpr bool PERM = true, PERM_A = false, SWAP = false, AFTER_DRAIN = false;
    const float* X; bf16_t* X1B; float* SSQ;
    __device__ __forceinline__ void operator()(const f32x4 (&acc)[2][2][4][2], const Unit& u, int wr, int wc, int fr, int fq) const {
        const int row0 = u.pm * BM + wr * 64 + fr, col0 = u.pn * BM + wc * 32 + 8 * fq;
#pragma unroll
        for (int ai = 0; ai < 2; ++ai)
#pragma unroll
            for (int m = 0; m < 4; ++m) { const int row = row0 + ai * HALF + m * 16; const size_t off = (size_t)row * 1024 + col0; float ss = 0.f;
#pragma unroll
                for (int bj = 0; bj < 2; ++bj) { const f32x4 xa = *(const f32x4*)(X + off + bj * HALF), xb = *(const f32x4*)(X + off + bj * HALF + 4);
                    const f32x4 v0 = acc[ai][bj][m][0] + xa, v1 = acc[ai][bj][m][1] + xb;
                    *(u32x4*)(X1B + off + bj * HALF) = pack8(v0, v1);
                    ss += (v0[0] * v0[0] + v0[1] * v0[1]) + (v0[2] * v0[2] + v0[3] * v0[3]) + (v1[0] * v1[0] + v1[1] * v1[1]) + (v1[2] * v1[2] + v1[3] * v1[3]); }
                ss += __shfl_xor(ss, 16); ss += __shfl_xor(ss, 32);
                if (fq == 0) SSQ[(size_t)row * 16 + u.pn * 4 + wc] = ss; }
    }
};
struct EpiRes1N {
    static constexpr bool PERM = true, PERM_A = false, SWAP = false, AFTER_DRAIN = false;
    const bf16_t* XN; bf16_t* X1B; float* SSQ; const PG8_LAS float* RT; const PG8_LAS float* GT; int PM0;
    __device__ __forceinline__ void operator()(const f32x4 (&acc)[2][2][4][2], const Unit& u, int wr, int wc, int fr, int fq) const {
        const int row0 = u.pm * BM + wr * 64 + fr, col0 = u.pn * BM + wc * 32 + 8 * fq;
        const PG8_LAS float* rt = RT + ((u.pm == PM0) ? 0 : 256) + wr * 64 + fr;
        float ri[8]; f32x4 gi[2][2];
#pragma unroll
        for (int k = 0; k < 8; ++k) ri[k] = rt[(k >> 2) * HALF + (k & 3) * 16];
#pragma unroll
        for (int bj = 0; bj < 2; ++bj) { gi[bj][0] = *(const PG8_LAS f32x4*)(GT + col0 + bj * HALF); gi[bj][1] = *(const PG8_LAS f32x4*)(GT + col0 + bj * HALF + 4); }
        __builtin_amdgcn_sched_barrier(0);
#pragma unroll
        for (int ai = 0; ai < 2; ++ai)
#pragma unroll
            for (int m = 0; m < 4; ++m) { const int row = row0 + ai * HALF + m * 16; const size_t off = (size_t)row * 1024 + col0; float ss = 0.f; const float rinv = ri[ai * 4 + m];
#pragma unroll
                for (int bj = 0; bj < 2; ++bj) { const u32x4 xw = *(const u32x4*)(XN + off + bj * HALF);
                    const f32x4 xa = (f32x4){bfl(xw.x), bfh(xw.x), bfl(xw.y), bfh(xw.y)} * rinv * gi[bj][0], xb = (f32x4){bfl(xw.z), bfh(xw.z), bfl(xw.w), bfh(xw.w)} * rinv * gi[bj][1];
                    const f32x4 v0 = acc[ai][bj][m][0] + xa, v1 = acc[ai][bj][m][1] + xb;
                    *(u32x4*)(X1B + off + bj * HALF) = pack8(v0, v1);
                    ss += (v0[0] * v0[0] + v0[1] * v0[1]) + (v0[2] * v0[2] + v0[3] * v0[3]) + (v1[0] * v1[0] + v1[1] * v1[1]) + (v1[2] * v1[2] + v1[3] * v1[3]); }
                ss += __shfl_xor(ss, 16); ss += __shfl_xor(ss, 32);
                if (fq == 0) SSQ[(size_t)row * 16 + u.pn * 4 + wc] = ss; }
    }
};
struct EpiUp {
    static constexpr bool PERM = true, PERM_A = false, SWAP = false, AFTER_DRAIN = false;
    static constexpr int HP = 4096 + 64;
    bf16_t* H; const float* SSQ; const PG8_LAS float* RL; int PM0;
    __device__ __forceinline__ void operator()(const f32x4 (&acc)[2][2][4][2], const Unit& u, int wr, int wc, int fr, int fq) const {
        const int row0 = u.pm * BM + wr * 64 + fr, col0 = u.pn * BM + wc * 32 + 8 * fq;
        const PG8_LAS float* rl = RL + ((u.pm == PM0) ? 0 : 256) + wr * 64 + fr;
#pragma unroll
        for (int ai = 0; ai < 2; ++ai)
#pragma unroll
            for (int m = 0; m < 4; ++m) { const int row = row0 + ai * HALF + m * 16; float r;
                if (PM0 >= 0) r = rl[ai * HALF + m * 16];
                else { const f32x4* sp = (const f32x4*)(SSQ + (size_t)row * 16); const f32x4 p = (sp[0] + sp[1]) + (sp[2] + sp[3]); r = __builtin_amdgcn_rsqf(((p[0] + p[1]) + (p[2] + p[3])) * (1.0f / 1024.0f) + 1e-6f); }
                bf16_t* rowp = H + (size_t)row * HP + col0;
#pragma unroll
                for (int bj = 0; bj < 2; ++bj) { f32x4 v0 = acc[ai][bj][m][0] * r, v1 = acc[ai][bj][m][1] * r;
#pragma unroll
                    for (int e = 0; e < 4; ++e) { const float a = fmaxf(v0[e], 0.f), c = fmaxf(v1[e], 0.f); v0[e] = a * a; v1[e] = c * c; }
                    *(u32x4*)(rowp + bj * HALF) = pack8(v0, v1); } }
    }
};
struct EpiRes2 {
    static constexpr bool PERM = true, PERM_A = false, SWAP = false, AFTER_DRAIN = false;
    bf16_t* X1B; float* SSQ;
    __device__ __forceinline__ void operator()(const f32x4 (&acc)[2][2][4][2], const Unit& u, int wr, int wc, int fr, int fq) const {
        const int row0 = u.pm * BM + wr * 64 + fr, col0 = u.pn * BM + wc * 32 + 8 * fq;
#pragma unroll
        for (int ai = 0; ai < 2; ++ai)
#pragma unroll
            for (int m = 0; m < 4; ++m) { const int row = row0 + ai * HALF + m * 16; const size_t off = (size_t)row * 1024 + col0; float ss = 0.f;
#pragma unroll
                for (int bj = 0; bj < 2; ++bj) { const u32x4 xw = *(const u32x4*)(X1B + off + bj * HALF);
                    const f32x4 xa = {bfl(xw.x), bfh(xw.x), bfl(xw.y), bfh(xw.y)}, xb = {bfl(xw.z), bfh(xw.z), bfl(xw.w), bfh(xw.w)};
                    const f32x4 v0 = acc[ai][bj][m][0] + xa, v1 = acc[ai][bj][m][1] + xb;
                    *(u32x4*)(X1B + off + bj * HALF) = pack8(v0, v1);
                    ss += (v0[0] * v0[0] + v0[1] * v0[1]) + (v0[2] * v0[2] + v0[3] * v0[3]) + (v1[0] * v1[0] + v1[1] * v1[1]) + (v1[2] * v1[2] + v1[3] * v1[3]); }
                ss += __shfl_xor(ss, 16); ss += __shfl_xor(ss, 32);
                if (fq == 0) SSQ[(size_t)row * 16 + u.pn * 4 + wc] = ss; }
    }
};

struct EpiY {
    static constexpr bool PERM = true, PERM_A = false, SWAP = false, AFTER_DRAIN = false;
    bf16_t* Y;
    __device__ __forceinline__ void operator()(const f32x4 (&acc)[2][2][4][2], const Unit& u, int wr, int wc, int fr, int fq) const {
        const int row0 = u.pm * BM + wr * 64 + fr, col0 = u.pn * BM + wc * 32 + 8 * fq;
#pragma unroll
        for (int ai = 0; ai < 2; ++ai)
#pragma unroll
            for (int m = 0; m < 4; ++m) { bf16_t* rowp = Y + (size_t)(row0 + ai * HALF + m * 16) * 1024 + col0;
#pragma unroll
                for (int bj = 0; bj < 2; ++bj) *(u32x4*)(rowp + bj * HALF) = pack8(acc[ai][bj][m][0], acc[ai][bj][m][1]); }
    }
};
template <class Epi, class Sched, bool ALIGN_EPI = false, bool SP2 = false>
__device__ __forceinline__ void gemm_phase(PG8_LAS unsigned char* lds, const Gemm g, const Sched& S, const Epi& E) {
    const int tid = threadIdx.x, wid = __builtin_amdgcn_readfirstlane(tid >> 6), lane = tid & 63, wr = wid >> 2, wc = wid & 3, fr = lane & 15, fq = lane >> 4;
    const int K = g.K, nt = K / BK;
    unsigned voffA[2], voffB[2];
#pragma unroll
    for (int i = 0; i < 2; ++i) { int R, C; stage_rc(tid * 16 + i * 8192, R, C); const int Rb = Epi::PERM ? ((R & ~31) + perm32(R & 31)) : R; const int Ra = Epi::PERM_A ? ((R & ~31) + perm32(R & 31)) : R;
        voffA[i] = (unsigned)(Ra * g.lda + C) * 2u; voffB[i] = (unsigned)(Rb * K + C) * 2u; }
    const size_t kstep = (size_t)(BK * 2);
    const size_t hstep = (size_t)HALF * K * 2;
    const size_t tstep = 2 * hstep;
    const size_t hstepA = (size_t)HALF * g.lda * 2, tstepA = 2 * hstepA;
    const unsigned ldsw = (unsigned)wid * 1024u;
    const int aoff = lds_byte(wr * 64 + fr, fq * 8), boff = lds_byte(wc * 32 + fr, fq * 8);
#define PG8_SA(b, h) (((b) * 2 + (h)) * HTB)
#define PG8_SB(b, h) ((4 + (b) * 2 + (h)) * HTB)
#define PG8_STAGE(bufoff, gbase, voff) do { _Pragma("unroll") for (int _i = 0; _i < 2; ++_i) \
        __builtin_amdgcn_global_load_lds((const unsigned*)((const char*)(gbase) + (voff)[_i]), (PG8_LAS unsigned*)(lds + (bufoff) + ldsw + _i * 8192), 16, 0, 0); } while (0)
#define PG8_LDA(dst, b, h) do { _Pragma("unroll") for (int m = 0; m < 4; ++m) _Pragma("unroll") for (int k = 0; k < 2; ++k) dst[m][k] = *(const PG8_LAS bf16x8*)(lds + PG8_SA(b, h) + aoff + m * 2048 + k * 1024); } while (0)
#define PG8_LDB(dst, b, h) do { _Pragma("unroll") for (int n = 0; n < 2; ++n) _Pragma("unroll") for (int k = 0; k < 2; ++k) dst[n][k] = *(const PG8_LAS bf16x8*)(lds + PG8_SB(b, h) + boff + n * 2048 + k * 1024); } while (0)
#define PG8_MMA(ai, bj, At, Bt) do { __builtin_amdgcn_s_setprio(1); _Pragma("unroll") for (int m = 0; m < 4; ++m) _Pragma("unroll") for (int n = 0; n < 2; ++n) _Pragma("unroll") for (int k = 0; k < 2; ++k) \
        acc[ai][bj][m][n] = Epi::SWAP ? __builtin_amdgcn_mfma_f32_16x16x32_bf16(At[m][k], Bt[n][k], acc[ai][bj][m][n], 0, 0, 0) : __builtin_amdgcn_mfma_f32_16x16x32_bf16(Bt[n][k], At[m][k], acc[ai][bj][m][n], 0, 0, 0); __builtin_amdgcn_s_setprio(0); } while (0)
#define PG8_WAIT_V(n) asm volatile("s_waitcnt vmcnt(" #n ")" ::: "memory")
#define PG8_WAIT_L(n) asm volatile("s_waitcnt lgkmcnt(" #n ")" ::: "memory")
#define PG8_BAR __builtin_amdgcn_s_barrier()
#define PG8_SCHED __builtin_amdgcn_sched_barrier(0)
    Unit cur, nxt; int ui = 0;
    if (!S.next(0, cur)) return;
    f32x4 acc[2][2][4][2];
#pragma unroll
    for (int a = 0; a < 2; ++a)
#pragma unroll
        for (int b = 0; b < 2; ++b)
#pragma unroll
            for (int m = 0; m < 4; ++m)
#pragma unroll
                for (int n = 0; n < 2; ++n) acc[a][b][m][n] = (f32x4){0.f, 0.f, 0.f, 0.f};
    bf16x8 At[4][2], B0[2][2], B1[2][2];
    const char* cA = (const char*)g.A + (size_t)cur.pm * tstepA; const char* cB = (const char*)g.Bt + (size_t)cur.pn * tstep;
    S.a_ready(cur);
    if constexpr (SP2) {
        PG8_STAGE(PG8_SB(0, 0), cB, voffB); PG8_STAGE(PG8_SB(0, 1), cB + hstep, voffB); PG8_STAGE(PG8_SA(0, 0), cA, voffA); PG8_STAGE(PG8_SA(0, 1), cA + hstepA, voffA);
        if (wr == 1) PG8_BAR;
        PG8_WAIT_V(2); PG8_BAR;
        PG8_STAGE(PG8_SB(1, 0), cB + kstep, voffB); PG8_STAGE(PG8_SA(1, 0), cA + kstep, voffA); PG8_STAGE(PG8_SB(1, 1), cB + hstep + kstep, voffB);
        PG8_WAIT_V(6); PG8_BAR;
    } else {
        PG8_STAGE(PG8_SB(0, 0), cB, voffB); PG8_STAGE(PG8_SA(0, 0), cA, voffA); PG8_STAGE(PG8_SB(0, 1), cB + hstep, voffB); PG8_STAGE(PG8_SA(0, 1), cA + hstepA, voffA);
        if (wr == 1) PG8_BAR;
        PG8_WAIT_V(4); PG8_BAR;
        PG8_STAGE(PG8_SB(1, 0), cB + kstep, voffB); PG8_STAGE(PG8_SA(1, 0), cA + kstep, voffA); PG8_STAGE(PG8_SB(1, 1), cB + hstep + kstep, voffB);
        PG8_WAIT_V(6); PG8_BAR;
    }
    for (;;) {
        const bool has_next = S.next(ui + 1, nxt);
        const char* nA = has_next ? (const char*)g.A + (size_t)nxt.pm * tstepA : cA; const char* nB = has_next ? (const char*)g.Bt + (size_t)nxt.pn * tstep : cB;
        for (int t = 0; t < nt; t += 2) {
            const bool last = (t == nt - 2);
            const char* a1 = cA + (size_t)(t + 1) * kstep;
            const char* a2 = last ? nA : cA + (size_t)(t + 2) * kstep; const char* b2 = last ? nB : cB + (size_t)(t + 2) * kstep;
            const char* a3 = a2 + kstep; const char* b3 = b2 + kstep;
            if (last && has_next) S.a_ready(nxt);
            if constexpr (SP2) {
            PG8_LDB(B0, 0, 0); PG8_LDB(B1, 0, 1); PG8_SCHED; PG8_LDA(At, 0, 0); PG8_STAGE(PG8_SA(1, 1), a1 + hstepA, voffA);
            PG8_WAIT_V(8); PG8_WAIT_L(0); PG8_BAR; PG8_MMA(0, 0, At, B0); PG8_MMA(0, 1, At, B1); PG8_BAR; PG8_SCHED;
            PG8_LDA(At, 0, 1); PG8_STAGE(PG8_SB(0, 0), b2, voffB); PG8_STAGE(PG8_SB(0, 1), b2 + hstep, voffB); PG8_STAGE(PG8_SA(0, 0), a2, voffA);
            PG8_WAIT_V(8); PG8_WAIT_L(0); PG8_BAR; PG8_MMA(1, 0, At, B0); PG8_MMA(1, 1, At, B1); PG8_BAR; PG8_SCHED;
            PG8_LDB(B0, 1, 0); PG8_LDB(B1, 1, 1); PG8_SCHED; PG8_LDA(At, 1, 0); PG8_STAGE(PG8_SA(0, 1), a2 + hstepA, voffA);
            PG8_WAIT_V(8); PG8_WAIT_L(0); PG8_BAR; PG8_MMA(0, 0, At, B0); PG8_MMA(0, 1, At, B1); PG8_BAR; PG8_SCHED;
            PG8_LDA(At, 1, 1); PG8_STAGE(PG8_SB(1, 0), b3, voffB); PG8_STAGE(PG8_SB(1, 1), b3 + hstep, voffB); PG8_STAGE(PG8_SA(1, 0), a3, voffA);
            PG8_WAIT_V(8); PG8_WAIT_L(0); PG8_BAR; PG8_MMA(1, 0, At, B0); PG8_MMA(1, 1, At, B1); PG8_BAR; PG8_SCHED;
            } else {
            PG8_LDB(B0, 0, 0); PG8_SCHED; PG8_LDA(At, 0, 0); PG8_STAGE(PG8_SA(1, 1), a1 + hstepA, voffA);
            PG8_WAIT_L(8); PG8_BAR; PG8_WAIT_L(0); PG8_MMA(0, 0, At, B0); PG8_BAR; PG8_SCHED;
            PG8_LDB(B1, 0, 1); PG8_STAGE(PG8_SB(0, 0), b2, voffB);
            PG8_BAR; PG8_WAIT_L(0); PG8_MMA(0, 1, At, B1); PG8_BAR;
            PG8_LDA(At, 0, 1); PG8_STAGE(PG8_SA(0, 0), a2, voffA);
            PG8_BAR; PG8_WAIT_L(0); PG8_MMA(1, 0, At, B0); PG8_BAR; PG8_SCHED;
            PG8_STAGE(PG8_SB(0, 1), b2 + hstep, voffB);
            PG8_WAIT_V(6); PG8_BAR; PG8_MMA(1, 1, At, B1); PG8_BAR;
            PG8_LDB(B0, 1, 0); PG8_SCHED; PG8_LDA(At, 1, 0); PG8_STAGE(PG8_SA(0, 1), a2 + hstepA, voffA);
            PG8_WAIT_L(8); PG8_BAR; PG8_WAIT_L(0); PG8_MMA(0, 0, At, B0); PG8_BAR; PG8_SCHED;
            PG8_LDB(B1, 1, 1); PG8_STAGE(PG8_SB(1, 0), b3, voffB);
            PG8_BAR; PG8_WAIT_L(0); PG8_MMA(0, 1, At, B1); PG8_BAR;
            PG8_LDA(At, 1, 1); PG8_STAGE(PG8_SA(1, 0), a3, voffA);
            PG8_BAR; PG8_WAIT_L(0); PG8_MMA(1, 0, At, B0); PG8_BAR; PG8_SCHED;
            PG8_STAGE(PG8_SB(1, 1), b3 + hstep, voffB);
            PG8_WAIT_V(6); PG8_BAR; PG8_MMA(1, 1, At, B1); PG8_BAR;
            }
        }
        if constexpr (ALIGN_EPI) { if (wr == 0) PG8_BAR; }
        if constexpr (!Epi::AFTER_DRAIN) { E(acc, cur, wr, wc, fr, fq); S.done(cur); }
        if (!has_next) break;
#pragma unroll
        for (int a = 0; a < 2; ++a)
#pragma unroll
            for (int b = 0; b < 2; ++b)
#pragma unroll
                for (int m = 0; m < 4; ++m)
#pragma unroll
                    for (int n = 0; n < 2; ++n) acc[a][b][m][n] = (f32x4){0.f, 0.f, 0.f, 0.f};
        cur = nxt; cA = nA; cB = nB; ++ui;
        if constexpr (ALIGN_EPI) { if (wr == 1) PG8_BAR; }
    }
    PG8_WAIT_V(0);
    if constexpr (!ALIGN_EPI) { if (wr == 0) PG8_BAR; }
    PG8_BAR;
    if constexpr (Epi::AFTER_DRAIN) { E.fused(acc, cur, wr, wc, fr, fq, lds, wid, lane); S.done(cur); }
#undef PG8_SA
#undef PG8_SB
#undef PG8_STAGE
#undef PG8_LDA
#undef PG8_LDB
#undef PG8_MMA
#undef PG8_WAIT_V
#undef PG8_WAIT_L
#undef PG8_BAR
#undef PG8_SCHED
}
}
#ifndef MK_N_LAUNCHES
#define MK_N_LAUNCHES 1
#endif
constexpr int N_PHASES = 7;
constexpr int NWAVES = 8;
constexpr int M = 32768, D = 1024, FF = 4096, NPROJ = 1536, T = 4096;
constexpr size_t MiB = 1u << 20;
constexpr size_t WS_WIN = 0, WS_WOUT = 4 * MiB, WS_WUP = 6 * MiB, WS_WDOWN = 14 * MiB, WS_WPOOL = 22 * MiB, WS_SSQ = 23 * MiB;
constexpr size_t WS_X1B = 32 * MiB, WS_H = 96 * MiB, WS_XN = 96 * MiB, WS_PROJ = 160 * MiB, WS_VT = 256 * MiB, WS_CAT = 288 * MiB, WS_Y = 360 * MiB, WS_END = 424 * MiB;
constexpr int LDS_MISC = 149504, LDS_BYTES = 149504 + 64;
constexpr size_t WS_CTL = 26 * MiB, CTL_BYTES = 16384, WS_RSTD = 30 * MiB;
#define LAS __attribute__((address_space(3)))
typedef unsigned short bf16_t;
typedef short bf16x8 __attribute__((ext_vector_type(8)));
typedef float f32x4 __attribute__((ext_vector_type(4)));
typedef unsigned u32x4 __attribute__((ext_vector_type(4)));
typedef unsigned u32x2 __attribute__((ext_vector_type(2)));
#define LDS_WAIT() asm volatile("s_waitcnt lgkmcnt(0)" ::: "memory")
using pg8::cvt_pk_bf16;
__device__ __forceinline__ float wave_sum(float v) {
#pragma unroll
    for (int o = 1; o < 64; o <<= 1) v += __shfl_xor(v, o);
    return v;
}
__device__ __forceinline__ float bf_lo(unsigned w) { return __builtin_bit_cast(float, w << 16); }
__device__ __forceinline__ float bf_hi(unsigned w) { return __builtin_bit_cast(float, w & 0xffff0000u); }

__device__ __forceinline__ void p0_transpose_item(const float* W, int K, int N, bf16_t* WT, const float* kscale, const float* nscale, LAS float* scr, int item, int lane) {
    const int nblk = N / 32, kb = item / nblk, nb = item % nblk, k0 = 64 * kb, n0 = 32 * nb;
    const float ns = nscale ? nscale[n0 + (lane & 31)] : 1.f;
#pragma unroll 8
    for (int i = 0; i < 32; ++i) { const int kk = 2 * i + (lane >> 5); float w = W[(size_t)(k0 + kk) * N + n0 + (lane & 31)]; if (kscale) w *= kscale[k0 + kk]; scr[kk * 33 + (lane & 31)] = w * ns; }
    LDS_WAIT(); asm volatile("" ::: "memory");
    const int c = lane & 7;
#pragma unroll
    for (int j = 0; j < 4; ++j) { const int n = (lane >> 3) + 8 * j; const LAS float* s = scr + (8 * c) * 33 + n;
        u32x4 o; o.x = cvt_pk_bf16(s[0 * 33], s[1 * 33]); o.y = cvt_pk_bf16(s[2 * 33], s[3 * 33]); o.z = cvt_pk_bf16(s[4 * 33], s[5 * 33]); o.w = cvt_pk_bf16(s[6 * 33], s[7 * 33]);
        *(u32x4*)(WT + (size_t)(n0 + n) * K + k0 + 8 * c) = o; }
    LDS_WAIT(); asm volatile("" ::: "memory");
}

struct Args { const float* in[11]; float* out; unsigned char* ws; int lo, hi; };

constexpr float LOG2E = 1.4426950408889634f;
constexpr int A_K = 0, A_V = 73728, A_TBL = 147456;
#define ATT_BAR() do { asm volatile("s_waitcnt lgkmcnt(0)" ::: "memory"); __builtin_amdgcn_s_barrier(); asm volatile("" ::: "memory"); } while (0)
#define ATT_GLDS(gp, ldsoff) __builtin_amdgcn_global_load_lds((const unsigned*)(gp), (LAS unsigned*)(lds + (ldsoff)), 16, 0, 0)
__device__ __forceinline__ void attn_phase(LAS unsigned char* lds, const bf16_t* __restrict__ PROJ, const bf16_t* __restrict__ KIMG, const bf16_t* __restrict__ VIMG, bf16_t* __restrict__ CAT, const float* __restrict__ rpb,
                                           int vcu, int G, int tid, int lane, int wave, bool first_dma_issued) {
    const int qi = lane & 15, g = lane >> 4, rr = wave >> 2, j = wave & 3;
    const int bs = (j == 0) ? 0 : ((j == 3) ? 32 : 16 * j - 8);
    const int qcol = 16 * j + qi, qc0 = min(max(qcol - 8, 0), 48);
    int idx[8];
#pragma unroll
    for (int jj = 0; jj < 8; ++jj) { const int kc = bs + 8 * g + jj; const bool ok = (kc >= qc0) && (kc < qc0 + 16); idx[jj] = ok ? (kc - qcol + 15) : 31; }
    unsigned koff[2][2], voff[4];
#pragma unroll
    for (int tt = 0; tt < 2; ++tt)
#pragma unroll
        for (int ks = 0; ks < 2; ++ks) { const int key = bs + 8 * (qi >> 2) + (qi & 3) + 4 * tt; koff[tt][ks] = (unsigned)(key * 128 + (((2 * g + ks) ^ ((key >> 1) & 7)) * 16)); }
#pragma unroll
    for (int nt = 0; nt < 4; ++nt) { const int cb = (bs >> 3) + g, dh = 32 * (nt >> 1) + 8 * (qi >> 2) + 4 * (nt & 1) + (qi & 3); voff[nt] = (unsigned)(cb * 1024 + ((dh ^ (4 * (cb & 1))) * 16)); }
    LAS float* tbl = (LAS float*)(lds + A_TBL);
    const unsigned dmaoff = (unsigned)wave * 1024u;
    for (int wu = vcu; wu < 256; wu += G) {
        const int bh = wu >> 2, s0 = (wu & 3) * 8, b = bh >> 3, h = bh & 7;
        const char* kimg = (const char*)KIMG + (size_t)bh * (64 * 8192) + tid * 16;
        const char* vimg = (const char*)VIMG + (size_t)bh * (64 * 8192) + tid * 16;
        const bf16_t* qbase = PROJ + ((size_t)b * T + qcol) * NPROJ + 512 + h * 64 + 16 * g;
        if (!(first_dma_issued && wu == vcu)) ATT_BAR();
        { const int row = tid >> 5, c = tid & 31; tbl[tid] = (row < 15 && c < 31) ? rpb[(h * 15 + row) * 31 + c] * LOG2E : -INFINITY; }
        int krlo = min(max(2 * s0 - 4, 0), 55);
        if (!(first_dma_issued && wu == vcu)) {
#pragma unroll
        for (int ii = 0; ii < 9; ++ii) { const int row = krlo + ii, slot = row % 9; ATT_GLDS(kimg + (size_t)row * 8192, A_K + slot * 8192 + dmaoff); ATT_GLDS(vimg + (size_t)row * 8192, A_V + slot * 8192 + dmaoff); }
        }
        bf16x8 qf0, qf1;
        { const bf16_t* qp = qbase + (size_t)((2 * s0 + rr) * 64) * NPROJ; qf0 = *(const bf16x8*)qp; qf1 = *(const bf16x8*)(qp + 8); }
        unsigned bpk[9][4]; int bkey = -1000;
        asm volatile("s_waitcnt vmcnt(0)" ::: "memory");
        asm volatile("" : "+v"(qf0), "+v"(qf1));
        ATT_BAR();
        for (int st = 0; st < 8; ++st) {
            const int s = s0 + st, r = 2 * s + rr, r0 = min(max(r - 4, 0), 56);
            int sl0 = krlo % 9;
            { const int key = (krlo - r) * 64 + (r0 - r);
              if (key != bkey) { bkey = key;
#pragma unroll
                for (int ii = 0; ii < 9; ++ii) { const int kr = krlo + ii; const int trow = ((kr >= r0) && (kr <= r0 + 7)) ? (kr - r + 7) : 15; const LAS float* tp = tbl + trow * 32;
#pragma unroll
                    for (int pp = 0; pp < 4; ++pp) bpk[ii][pp] = pg8::cvt_pk_bf16(tp[idx[2 * pp]], tp[idx[2 * pp + 1]]); } } }
            f32x4 sc[9][2];
            { int sl = sl0;
              bf16x8 kb[2][2][2];
#define ATT_LOADK(ii_, buf_) do { const unsigned base_ = (unsigned)(A_K + sl * 8192); \
                _Pragma("unroll") for (int tt = 0; tt < 2; ++tt) { kb[buf_][tt][0] = *(const LAS bf16x8*)(lds + base_ + koff[tt][0]); kb[buf_][tt][1] = *(const LAS bf16x8*)(lds + base_ + koff[tt][1]); } \
                sl = (sl == 8) ? 0 : sl + 1; } while (0)
              ATT_LOADK(0, 0);
#pragma unroll
              for (int ii = 0; ii < 9; ++ii) {
                if (ii < 8) ATT_LOADK(ii + 1, (ii + 1) & 1);
                __builtin_amdgcn_sched_barrier(0);
#pragma unroll
                for (int tt = 0; tt < 2; ++tt) { f32x4 a = {bf_lo(bpk[ii][2 * tt]), bf_hi(bpk[ii][2 * tt]), bf_lo(bpk[ii][2 * tt + 1]), bf_hi(bpk[ii][2 * tt + 1])};
                    a = __builtin_amdgcn_mfma_f32_16x16x32_bf16(kb[ii & 1][tt][0], qf0, a, 0, 0, 0);
                    a = __builtin_amdgcn_mfma_f32_16x16x32_bf16(kb[ii & 1][tt][1], qf1, a, 0, 0, 0);
                    sc[ii][tt] = a; }
                __builtin_amdgcn_sched_barrier(0);
              }
#undef ATT_LOADK
            }
            ATT_BAR();
            const int sn = min(s + 1, 31), krn = min(max(2 * sn - 4, 0), 55);
            { const int ra = krn + 7, rb = krn + 8; ATT_GLDS(kimg + (size_t)ra * 8192, A_K + (ra % 9) * 8192 + dmaoff); ATT_GLDS(kimg + (size_t)rb * 8192, A_K + (rb % 9) * 8192 + dmaoff); }
            bf16x8 qn0, qn1;
            { const bf16_t* qp = qbase + (size_t)((2 * sn + rr) * 64) * NPROJ; qn0 = *(const bf16x8*)qp; qn1 = *(const bf16x8*)(qp + 8); }
            float mx = -INFINITY;
#pragma unroll
            for (int ii = 0; ii < 9; ++ii)
#pragma unroll
                for (int jj = 0; jj < 8; ++jj) mx = fmaxf(mx, sc[ii][jj >> 2][jj & 3]);
            mx = fmaxf(mx, __shfl_xor(mx, 16)); mx = fmaxf(mx, __shfl_xor(mx, 32));
            float sum = 0.f;
            bf16x8 pf[9];
#pragma unroll
            for (int ii = 0; ii < 9; ++ii) {
#pragma unroll
                for (int jj = 0; jj < 8; ++jj) { const float p = __builtin_amdgcn_exp2f(sc[ii][jj >> 2][jj & 3] - mx); sc[ii][jj >> 2][jj & 3] = p; sum += p; }
                const u32x4 w = pg8::pack8(sc[ii][0], sc[ii][1]); pf[ii] = __builtin_bit_cast(bf16x8, w); }
            sum += __shfl_xor(sum, 16); sum += __shfl_xor(sum, 32);
            const float inv = 1.0f / sum;
            asm volatile("s_waitcnt vmcnt(4)" ::: "memory");
            ATT_BAR();
            f32x4 o[4];
#pragma unroll
            for (int nt = 0; nt < 4; ++nt) o[nt] = (f32x4){0.f, 0.f, 0.f, 0.f};
            { int sl = sl0;
              bf16x8 vb[2][4];
#define ATT_LOADV(buf_) do { const unsigned base_ = (unsigned)(A_V + sl * 8192); _Pragma("unroll") for (int nt = 0; nt < 4; ++nt) vb[buf_][nt] = *(const LAS bf16x8*)(lds + base_ + voff[nt]); sl = (sl == 8) ? 0 : sl + 1; } while (0)
              ATT_LOADV(0);
#pragma unroll
              for (int ii = 0; ii < 9; ++ii) {
                if (ii < 8) ATT_LOADV((ii + 1) & 1);
                __builtin_amdgcn_sched_barrier(0);
#pragma unroll
                for (int nt = 0; nt < 4; ++nt) o[nt] = __builtin_amdgcn_mfma_f32_16x16x32_bf16(vb[ii & 1][nt], pf[ii], o[nt], 0, 0, 0);
                __builtin_amdgcn_sched_barrier(0);
              }
#undef ATT_LOADV
            }
            ATT_BAR();
            asm volatile("s_waitcnt vmcnt(0)" ::: "memory");
            asm volatile("" : "+v"(qn0), "+v"(qn1));
            qf0 = qn0; qf1 = qn1;
            { const int ra = krn + 7, rb = krn + 8; ATT_GLDS(vimg + (size_t)ra * 8192, A_V + (ra % 9) * 8192 + dmaoff); ATT_GLDS(vimg + (size_t)rb * 8192, A_V + (rb % 9) * 8192 + dmaoff); }
            bf16_t* op = CAT + ((size_t)b * T + r * 64 + qcol) * 1024 + 512 + h * 64 + 8 * g;
            *(u32x4*)op = pg8::pack8(o[0] * inv, o[1] * inv);
            *(u32x4*)(op + 32) = pg8::pack8(o[2] * inv, o[3] * inv);
            ATT_BAR();
            krlo = krn;
        }
        asm volatile("s_waitcnt vmcnt(0)" ::: "memory");
    }
    ATT_BAR();
}

__device__ __forceinline__ void pool_wave_group(const bf16_t* __restrict__ PROJ, const bf16_t* __restrict__ WPT, bf16_t* __restrict__ CAT, int gi, int tile_first, int tile_step, int lane) {
    const int qi = lane & 15, g = lane >> 4;
    const int w = 2 << gi, half = w >> 1;
    const unsigned ulane = (unsigned)((8 * (qi >> 2) + (qi & 3)) * NPROJ + 8 * g) * 2u;
    const char* wbase = (const char*)(WPT + (size_t)gi * 16384);
    const unsigned wlane = (unsigned)((8 * (qi >> 2) + (qi & 3)) * 128 + 8 * g) * 2u;
    bf16x8 wf[4][2][4];
#pragma unroll
    for (int np = 0; np < 4; ++np)
#pragma unroll
        for (int e = 0; e < 2; ++e)
#pragma unroll
            for (int ks = 0; ks < 4; ++ks) wf[np][e][ks] = *(const bf16x8*)(wbase + ((32 * np + 4 * e) * 128 + 32 * ks) * 2 + wlane);
    bf16x8 ua[4], ub[4];
    if (tile_first < M / 16) {
        const char* ubase = (const char*)(PROJ + ((long)tile_first * 16 - 8) * NPROJ + gi * 128);
#pragma unroll
        for (int ks = 0; ks < 4; ++ks) { ua[ks] = *(const bf16x8*)(ubase + ks * 64 + ulane); ub[ks] = *(const bf16x8*)(ubase + 4 * NPROJ * 2 + ks * 64 + ulane); }
    }
    for (int tile16 = tile_first; tile16 < M / 16; tile16 += tile_step) {
        bf16x8 ca[4], cb[4];
#pragma unroll
        for (int ks = 0; ks < 4; ++ks) { ca[ks] = ua[ks]; cb[ks] = ub[ks]; }
        { const int tn = (tile16 + tile_step < M / 16) ? tile16 + tile_step : tile16;
          const char* ubase = (const char*)(PROJ + ((long)tn * 16 - 8) * NPROJ + gi * 128);
#pragma unroll
          for (int ks = 0; ks < 4; ++ks) { ua[ks] = *(const bf16x8*)(ubase + ks * 64 + ulane); ub[ks] = *(const bf16x8*)(ubase + 4 * NPROJ * 2 + ks * 64 + ulane); } }
        const int t0 = (tile16 * 16) & (T - 1);
        const int tq = t0 + qi, lo = max(tq - half, 0), hi = min(tq - half + w, T);
        const float invn = 1.0f / (float)(hi - lo);
        float pv[8];
#pragma unroll
        for (int jj = 0; jj < 8; ++jj) { const int tp = t0 - 8 + 8 * g + jj; pv[jj] = ((tp >= lo && tp < hi) ? invn : 0.f) - ((tp == tq) ? 1.f : 0.f); }
        const u32x4 pmw = pg8::pack8((f32x4){pv[0], pv[1], pv[2], pv[3]}, (f32x4){pv[4], pv[5], pv[6], pv[7]});
        const bf16x8 pm = __builtin_bit_cast(bf16x8, pmw);
        __builtin_amdgcn_sched_barrier(0);
        bf16_t* op = CAT + ((size_t)tile16 * 16 + qi) * 1024 + gi * 128 + 8 * g;
#pragma unroll
        for (int np = 0; np < 4; ++np) {
            f32x4 c[2];
#pragma unroll
            for (int e = 0; e < 2; ++e) {
                f32x4 za = {0.f, 0.f, 0.f, 0.f}, zb = {0.f, 0.f, 0.f, 0.f};
#pragma unroll
                for (int ks = 0; ks < 4; ++ks) { za = __builtin_amdgcn_mfma_f32_16x16x32_bf16(ca[ks], wf[np][e][ks], za, 0, 0, 0); zb = __builtin_amdgcn_mfma_f32_16x16x32_bf16(cb[ks], wf[np][e][ks], zb, 0, 0, 0); }
                const u32x4 zw = pg8::pack8(za, zb);
                c[e] = __builtin_amdgcn_mfma_f32_16x16x32_bf16(__builtin_bit_cast(bf16x8, zw), pm, (f32x4){0.f, 0.f, 0.f, 0.f}, 0, 0, 0);
            }
            *(u32x4*)(op + 32 * np) = pg8::pack8(c[0], c[1]);
        }
    }
}

typedef __attribute__((address_space(1))) unsigned gu32;
#define RLX_AGENT __ATOMIC_RELAXED, __HIP_MEMORY_SCOPE_AGENT
#define XB_TMO      128
#define XB_XCNT(j)  (256  + 64 * (j))
#define XB_XSUB(j)  (1280 + 64 * (j))
#define XB_XGEN(j)  (2304 + 64 * (j))
#define XB_TOP      3328
#define XB_TOPGEN   3392
#define XCD_BAR_WORDS 3456
#define XB_SPIN_CAP (1u << 18)

__device__ __forceinline__ unsigned xb_ld(unsigned* p)              { return __hip_atomic_load(p, __ATOMIC_RELAXED, __HIP_MEMORY_SCOPE_AGENT); }
__device__ __forceinline__ unsigned xb_add(unsigned* p, unsigned v) { return __hip_atomic_fetch_add(p, v, __ATOMIC_RELAXED, __HIP_MEMORY_SCOPE_AGENT); }
__device__ __forceinline__ unsigned xb_xcc_id() { return (unsigned)__builtin_amdgcn_s_getreg((3 << 11) | 20) & 0xFu; }
#define XB_SPIN(cond, bar) do { unsigned _sp = 0; while (cond) { __builtin_amdgcn_s_sleep(1); \
    if ((++_sp & 255u) == 0u) { if (xb_ld(&(bar)[XB_TMO])) break; if (_sp > XB_SPIN_CAP) { atomicAdd(&(bar)[XB_TMO], 1u); break; } } } } while (0)

struct XcdBarrier {
    unsigned* bar; unsigned x;
    volatile LAS unsigned* st;
};

__device__ __forceinline__ XcdBarrier xcd_barrier_post(unsigned* bar, volatile LAS unsigned* st) {
    XcdBarrier b; b.bar = bar; b.x = xb_xcc_id(); b.st = st;
    if (threadIdx.x == 0) (void)xb_add(&bar[XB_XCNT(b.x)], 1u);
    return b;
}
__device__ __forceinline__ void xcd_barrier_complete(unsigned* bar, unsigned x, unsigned& nloc, unsigned& nx) {
    const unsigned G = gridDim.x * gridDim.y * gridDim.z;
    unsigned sum, cnt, mine, sp = 0u;
    for (;;) {
        sum = 0u; cnt = 0u; mine = 0u;
#pragma unroll
        for (unsigned j = 0; j < 16; ++j) { const unsigned c = xb_ld(&bar[XB_XCNT(j)]); sum += c; cnt += (c > 0u) ? 1u : 0u; mine = (j == x) ? c : mine; }
        if (sum == G) break;
        __builtin_amdgcn_s_sleep(1);
        if ((++sp & 255u) == 0u) { if (xb_ld(&bar[XB_TMO])) break; if (sp > XB_SPIN_CAP) { atomicAdd(&bar[XB_TMO], 1u); break; } }
    }
    nloc = mine > 0u ? mine : 1u; nx = cnt > 0u ? cnt : 1u;
}

__device__ __forceinline__ void xcd_barrier(const XcdBarrier& b) {
    asm volatile("s_waitcnt vmcnt(0)" ::: "memory");
    __syncthreads();
    if (threadIdx.x == 0) {
        unsigned* bar = b.bar;
        __builtin_amdgcn_s_waitcnt(0);
        unsigned nloc = b.st[0], nx = b.st[1];
        if (nloc == 0u) { xcd_barrier_complete(bar, b.x, nloc, nx); b.st[0] = nloc; b.st[1] = nx; }
        const unsigned old = xb_add(&bar[XB_XSUB(b.x)], 1u);
        const unsigned gen = old / nloc;
        if (old + 1u == (gen + 1u) * nloc) {
            __builtin_amdgcn_fence(__ATOMIC_RELEASE, "agent");
            asm volatile("s_waitcnt vmcnt(0)" ::: "memory");
            const unsigned og = xb_add(&bar[XB_TOP], 1u);
            const unsigned tg = og / nx;
            if (og + 1u == (tg + 1u) * nx) xb_add(&bar[XB_TOPGEN], 1u);
            else XB_SPIN(xb_ld(&bar[XB_TOPGEN]) == tg, bar);
            __builtin_amdgcn_fence(__ATOMIC_ACQUIRE, "agent");
            xb_add(&bar[XB_XGEN(b.x)], 1u);
            asm volatile("s_waitcnt vmcnt(0)" ::: "memory");
        } else {
            XB_SPIN(xb_ld(&bar[XB_XGEN(b.x)]) == gen, bar);
            __builtin_amdgcn_fence(__ATOMIC_ACQUIRE, "agent");
            asm volatile("s_waitcnt vmcnt(0)" ::: "memory");
        }
    }
    __syncthreads();
}

__global__ void __launch_bounds__(NWAVES * 64, 2) mk_fwd(Args args) {
    extern __shared__ __attribute__((aligned(16))) unsigned char lds_raw[];
    LAS unsigned char* lds = (LAS unsigned char*)lds_raw;
    const int tid = threadIdx.x, lane = tid & 63, wave = __builtin_amdgcn_readfirstlane(tid >> 6);
    const int G = gridDim.x, bx = blockIdx.x;
    const int vcu = (G % 8 == 0) ? (bx % 8) * (G / 8) + bx / 8 : bx;
    const int gw = vcu * NWAVES + wave, NGW = G * NWAVES;
    unsigned char* ws = args.ws;
    const float* x = args.in[0]; const float* g1 = args.in[1]; const float* w_in = args.in[2]; const float* w_pool = args.in[3]; const float* pool_scale = args.in[4];
    const float* rpb = args.in[5]; const float* w_out = args.in[6]; const float* g2 = args.in[7]; const float* w_up = args.in[8]; const float* w_down = args.in[9]; const float* gf = args.in[10];
    float* out = args.out;
    bf16_t* WIN_T = (bf16_t*)(ws + WS_WIN); bf16_t* WOUT_T = (bf16_t*)(ws + WS_WOUT); bf16_t* WUP_T = (bf16_t*)(ws + WS_WUP); bf16_t* WDOWN_T = (bf16_t*)(ws + WS_WDOWN); bf16_t* WPOOL_T = (bf16_t*)(ws + WS_WPOOL);
    float* SSQ = (float*)(ws + WS_SSQ); float* RSTD1 = (float*)(ws + WS_RSTD);
    bf16_t* X1B = (bf16_t*)(ws + WS_X1B); bf16_t* HB = (bf16_t*)(ws + WS_H); bf16_t* XN = (bf16_t*)(ws + WS_XN); bf16_t* PROJ = (bf16_t*)(ws + WS_PROJ); bf16_t* VT = (bf16_t*)(ws + WS_VT); bf16_t* KIMG = (bf16_t*)(ws + WS_X1B); bf16_t* CAT = (bf16_t*)(ws + WS_CAT);
    const int lo = args.lo, hi = args.hi;
#define IN(k) (lo <= (k) && (k) < hi)
#ifndef DUP_PHASE
#define DUP_PHASE -1
#endif
#define REP(k) for (int rep_ = 0; rep_ < ((k) == DUP_PHASE ? 2 : 1); ++rep_)
#define SEAM(k) do { if (IN(k) && IN((k) + 1)) xcd_barrier(bar); } while (0)
    volatile LAS unsigned* misc = (volatile LAS unsigned*)(lds + LDS_MISC);
    if (tid < 16) misc[tid] = 0u;
    __syncthreads();
    XcdBarrier bar; bar.bar = (unsigned*)(ws + WS_CTL); bar.x = 0; bar.st = nullptr;
    if (hi - lo > 1) bar = xcd_barrier_post((unsigned*)(ws + WS_CTL), misc);
    if (lo > N_PHASES) cg::this_grid().sync();

    if (IN(0)) REP(0) {
        LAS float* scr = (LAS float*)(lds + wave * 16384);
        constexpr int I_IN = (D / 64) * (2048 / 32), I_OUT = (D / 64) * (D / 32), I_UP = (D / 64) * (FF / 32), I_DN = (FF / 64) * (D / 32), I_PL = 2 * 4;
        constexpr int NITEMS = I_IN + I_OUT + I_UP + I_DN + 4 * I_PL;
        f32x4 gv[4];
#pragma unroll
        for (int j = 0; j < 4; ++j) gv[j] = ((const f32x4*)g1)[lane + 64 * j];
        for (int pass = 0; pass < 2; ++pass) {
        if (((wave & 1) == 0) == (pass == 0)) {
        for (int it = gw; it < NITEMS; it += NGW) {
            int r = it;
            if (r < I_IN) { p0_transpose_item(w_in, D, 2048, WIN_T, nullptr, nullptr, scr, r, lane); continue; } r -= I_IN;
            if (r < I_OUT) { p0_transpose_item(w_out, D, D, WOUT_T, nullptr, nullptr, scr, r, lane); continue; } r -= I_OUT;
            if (r < I_UP) { p0_transpose_item(w_up, D, FF, WUP_T, g2, nullptr, scr, r, lane); continue; } r -= I_UP;
            if (r < I_DN) { p0_transpose_item(w_down, FF, D, WDOWN_T, nullptr, nullptr, scr, r, lane); continue; } r -= I_DN;
            const int gi = r / I_PL; r -= gi * I_PL;
            p0_transpose_item(w_pool + (size_t)gi * 16384, 128, 128, WPOOL_T + (size_t)gi * 16384, nullptr, pool_scale + gi * 128, scr, r, lane);
        }
        } else {
        for (int m = gw; m < M; m += NGW) {
            const f32x4* xr = (const f32x4*)(x + (size_t)m * D) + lane; f32x4 v[4]; float s = 0.f;
#pragma unroll
            for (int j = 0; j < 4; ++j) { v[j] = xr[64 * j]; s += (v[j].x * v[j].x + v[j].y * v[j].y) + (v[j].z * v[j].z + v[j].w * v[j].w); }
            const float rstd = __builtin_amdgcn_rsqf(wave_sum(s) * (1.f / D) + 1e-6f);
            if (lane == 0) RSTD1[m] = rstd;
            u32x2* o8 = (u32x2*)(XN + (size_t)m * D) + lane;
#pragma unroll
            for (int j = 0; j < 4; ++j) { const f32x4 y = v[j] * rstd * gv[j]; u32x2 w; w.x = cvt_pk_bf16(y.x, y.y); w.y = cvt_pk_bf16(y.z, y.w); o8[64 * j] = w; }
        }
        } }
    }
    SEAM(0);
    if (IN(1)) REP(1) {
        { pg8::Gemm g{XN, WIN_T, M, NPROJ, D, D}; pg8::StaticOrder S; S.init(M, NPROJ, G, bx); pg8::EpiProj E{PROJ, NPROJ, KIMG};
          pg8::gemm_phase<pg8::EpiProj, pg8::StaticOrder, true, true>(lds, g, S, E); }
        { pg8::Gemm g{XN, WIN_T + (size_t)NPROJ * D, M, 512, D, D}; pg8::StaticOrder S; S.init(M, 512, G, bx); pg8::EpiVT E{VT};
          pg8::gemm_phase<pg8::EpiVT, pg8::StaticOrder, true, true>(lds, g, S, E); }
    }
    SEAM(1);
    if (IN(2)) REP(2) {
        const bool pre = (vcu < 256);
        if (pre) {
            const int bh = vcu >> 2, s0 = (vcu & 3) * 8, krlo = min(max(2 * s0 - 4, 0), 55);
            const char* kimg = (const char*)KIMG + (size_t)bh * (64 * 8192) + tid * 16; const char* vimg = (const char*)VT + (size_t)bh * (64 * 8192) + tid * 16;
            ATT_BAR();
#pragma unroll
            for (int ii = 0; ii < 9; ++ii) { const int row = krlo + ii, slot = row % 9; ATT_GLDS(kimg + (size_t)row * 8192, A_K + slot * 8192 + wave * 1024); ATT_GLDS(vimg + (size_t)row * 8192, A_V + slot * 8192 + wave * 1024); }
        }
        pool_wave_group(PROJ, WPOOL_T, CAT, wave & 3, vcu * 2 + (wave >> 2), G * 2, lane);
        attn_phase(lds, PROJ, KIMG, VT, CAT, rpb, vcu, G, tid, lane, wave, pre);
        __syncthreads();
    }
    SEAM(2);
    if (IN(3)) REP(3) {
        pg8::Gemm g{CAT, WOUT_T, M, D, D, D}; pg8::StaticOrder S; S.init(M, D, G, bx);
        LAS float* rt3 = (LAS float*)(lds + 131072); LAS float* gt3 = rt3 + 512;
        pg8::Unit ua, ub; const bool two = (G == 256) && S.next(0, ua) && S.next(1, ub);
        int gok = 1;
        if (two) { rt3[tid] = 1.0f / RSTD1[((tid < 256) ? ua.pm : ub.pm) * 256 + (tid & 255)];
            const float ga = g1[tid], gb = g1[tid + 512]; gt3[tid] = 1.0f / ga; gt3[tid + 512] = 1.0f / gb; gok = (fabsf(ga) > 1e-3f) && (fabsf(gb) > 1e-3f); }
        gok = __syncthreads_and(gok);
        if (two && gok) { pg8::EpiRes1N E{XN, X1B, SSQ, rt3, gt3, ua.pm}; pg8::gemm_phase<pg8::EpiRes1N, pg8::StaticOrder, true, true>(lds, g, S, E); }
        else { pg8::EpiRes1 E{x, X1B, SSQ}; pg8::gemm_phase<pg8::EpiRes1, pg8::StaticOrder, true, true>(lds, g, S, E); }
    }
    SEAM(3);
    if (IN(4)) REP(4) {
        pg8::Gemm g{X1B, WUP_T, M, FF, D, D}; pg8::StaticOrder S; S.init(M, FF, G, bx);
        pg8::Unit ua, ub; const bool two = (G == 256) && S.next(0, ua) && S.next(4, ub);
        LAS float* rl = (LAS float*)(lds + 131072);
        if (two) { const int row = ((tid < 256) ? ua.pm : ub.pm) * 256 + (tid & 255); const f32x4* sp = (const f32x4*)(SSQ + (size_t)row * 16);
            const f32x4 p = (sp[0] + sp[1]) + (sp[2] + sp[3]); rl[tid] = __builtin_amdgcn_rsqf(((p[0] + p[1]) + (p[2] + p[3])) * (1.0f / 1024.0f) + 1e-6f); }
        __syncthreads();
        pg8::EpiUp E{HB, SSQ, rl, two ? ua.pm : -1};
        pg8::gemm_phase<pg8::EpiUp, pg8::StaticOrder, true, true>(lds, g, S, E);
    }
    SEAM(4);
    if (IN(5)) REP(5) {
        pg8::Gemm g{HB, WDOWN_T, M, D, FF, pg8::EpiUp::HP}; pg8::StaticOrder S; S.init(M, D, G, bx); pg8::EpiY E{(bf16_t*)(ws + WS_Y)};
        pg8::gemm_phase<pg8::EpiY, pg8::StaticOrder, false, true>(lds, g, S, E);
    }
    SEAM(5);
    if (IN(6)) {
        const bf16_t* YB = (const bf16_t*)(ws + WS_Y);
        f32x4 gv[4];
#pragma unroll
        for (int j = 0; j < 2; ++j) { gv[2 * j] = ((const f32x4*)gf)[2 * lane + 128 * j]; gv[2 * j + 1] = ((const f32x4*)gf)[2 * lane + 128 * j + 1]; }
        for (int m = gw; m < M; m += NGW) {
            const u32x4* xr = (const u32x4*)(X1B + (size_t)m * D) + lane; const u32x4* yr = (const u32x4*)(YB + (size_t)m * D) + lane;
            const u32x4 w0 = xr[0], w1 = xr[64], y0 = yr[0], y1 = yr[64];
            const f32x4 a0 = (f32x4){bf_lo(w0.x), bf_hi(w0.x), bf_lo(w0.y), bf_hi(w0.y)} + (f32x4){bf_lo(y0.x), bf_hi(y0.x), bf_lo(y0.y), bf_hi(y0.y)};
            const f32x4 a1 = (f32x4){bf_lo(w0.z), bf_hi(w0.z), bf_lo(w0.w), bf_hi(w0.w)} + (f32x4){bf_lo(y0.z), bf_hi(y0.z), bf_lo(y0.w), bf_hi(y0.w)};
            const f32x4 a2 = (f32x4){bf_lo(w1.x), bf_hi(w1.x), bf_lo(w1.y), bf_hi(w1.y)} + (f32x4){bf_lo(y1.x), bf_hi(y1.x), bf_lo(y1.y), bf_hi(y1.y)};
            const f32x4 a3 = (f32x4){bf_lo(w1.z), bf_hi(w1.z), bf_lo(w1.w), bf_hi(w1.w)} + (f32x4){bf_lo(y1.z), bf_hi(y1.z), bf_lo(y1.w), bf_hi(y1.w)};
            float s = ((a0.x * a0.x + a0.y * a0.y) + (a0.z * a0.z + a0.w * a0.w)) + ((a1.x * a1.x + a1.y * a1.y) + (a1.z * a1.z + a1.w * a1.w))
                    + ((a2.x * a2.x + a2.y * a2.y) + (a2.z * a2.z + a2.w * a2.w)) + ((a3.x * a3.x + a3.y * a3.y) + (a3.z * a3.z + a3.w * a3.w));
            const float rstd = __builtin_amdgcn_rsqf(wave_sum(s) * (1.f / D) + 1e-6f);
            f32x4* orow = (f32x4*)(out + (size_t)m * D) + 2 * lane;
            orow[0] = a0 * rstd * gv[0]; orow[1] = a1 * rstd * gv[1]; orow[128] = a2 * rstd * gv[2]; orow[129] = a3 * rstd * gv[3];
        }
    }
#undef IN
#undef SEAM
}

extern "C" void kernel_launch(void* const* d_in, const int* in_sizes, int n_in, void* d_out, int out_size, void* d_ws, size_t ws_size, hipStream_t stream) {
    static int grid = 0;
    if (grid == 0) {
        if (n_in != 11 || in_sizes[0] != M * D || out_size != M * D || ws_size < WS_END) { fprintf(stderr, "kernel_launch: unexpected shapes (n_in %d, in0 %d, out %d, ws %zu); nothing launched\n", n_in, n_in > 0 ? in_sizes[0] : -1, out_size, ws_size); grid = -1; return; }
        int dev = 0, cus = 0, per_cu = 0;
        if (hipGetDevice(&dev) != hipSuccess || hipDeviceGetAttribute(&cus, hipDeviceAttributeMultiprocessorCount, dev) != hipSuccess) { grid = -1; return; }
        if (hipFuncSetAttribute((const void*)mk_fwd, hipFuncAttributeMaxDynamicSharedMemorySize, LDS_BYTES) != hipSuccess) { fprintf(stderr, "kernel_launch: hipFuncSetAttribute failed\n"); grid = -1; return; }
        if (hipOccupancyMaxActiveBlocksPerMultiprocessor(&per_cu, (const void*)mk_fwd, NWAVES * 64, LDS_BYTES) != hipSuccess || per_cu < 1) { fprintf(stderr, "kernel_launch: occupancy query says %d\n", per_cu); per_cu = 1; }
        (void)hipGetLastError();
        grid = cus * 1;
    }
    if (grid < 0) return;
    Args a{};
    for (int i = 0; i < 11; ++i) a.in[i] = (const float*)d_in[i];
    a.out = (float*)d_out; a.ws = (unsigned char*)d_ws;
#if MK_N_LAUNCHES == 1
    a.lo = 0; a.hi = N_PHASES;
    if (hipMemsetAsync((char*)d_ws + WS_CTL, 0, CTL_BYTES, stream) != hipSuccess) { fprintf(stderr, "kernel_launch: memset of the barrier words failed\n"); return; }
    void* kargs[] = {&a};
    hipError_t e = hipLaunchCooperativeKernel((const void*)mk_fwd, dim3(grid), dim3(NWAVES * 64), kargs, LDS_BYTES, stream);
    if (e != hipSuccess) fprintf(stderr, "kernel_launch: cooperative launch failed: %s (grid %d)\n", hipGetErrorString(e), grid);
#else
    for (int p = 0; p < N_PHASES; ++p) { a.lo = p; a.hi = p + 1; hipLaunchKernelGGL(mk_fwd, dim3(grid), dim3(NWAVES * 64), LDS_BYTES, stream, a); }
#endif
}
```

```cpp
#define MK_N_LAUNCHES 1
#define DUP_PHASE -1
#include <hip/hip_runtime.h>
#include <hip/hip_cooperative_groups.h>
#include <cstdio>
#include <cstdint>
#include <cmath>
namespace cg = cooperative_groups;
namespace pg8 {
#define PG8_LAS __attribute__((address_space(3)))
typedef unsigned short bf16_t;
typedef short bf16x8 __attribute__((ext_vector_type(8)));
typedef float f32x4 __attribute__((ext_vector_type(4)));
typedef unsigned u32x4 __attribute__((ext_vector_type(4)));
constexpr int BM = 256, BK = 64, HALF = 128, HTB = HALF * BK * 2  , STAGE_BYTES = 8 * HTB, NXCD = 8, WGM = 8;

__host__ __device__ __forceinline__ int lds_byte(int r, int c) { const int st = (r >> 4) * 2 + (c >> 5), rr = r & 15, cc = c & 31, ob = rr * 64 + cc * 2; return st * 1024 + (ob ^ (((ob >> 9) & 1) << 5)); }
__host__ __device__ __forceinline__ void stage_rc(int b, int& R, int& C) { const int st = b / 1024, sb = b % 1024, swz = sb ^ (((sb >> 9) & 1) << 5); R = (st >> 1) * 16 + swz / 64; C = (st & 1) * 32 + (swz % 64) / 2; }
__host__ __device__ __forceinline__ int perm32(int rho) { const int n = rho >> 4, i = rho & 15; return 8 * (i >> 2) + 4 * n + (i & 3); }

struct Unit { int pm, pn; };
struct Gemm { const bf16_t* A; const bf16_t* Bt; int M, N, K, lda; };

struct StaticOrder {
    int nM, nN, nwg, G, c;
    __host__ __device__ void init(int M, int N, int G_, int c_) { nM = M / BM; nN = N / BM; nwg = nM * nN; G = G_; c = c_; }
    __host__ __device__ bool next(int i, Unit& u) const {
        const long L = (long)i * G + c; if (L >= nwg) return false;
        int wgid = (int)L; { const int q = nwg / NXCD, r = nwg % NXCD, xcd = wgid % NXCD, off = wgid / NXCD; wgid = (xcd < r ? xcd * (q + 1) : r * (q + 1) + (xcd - r) * q) + off; }
        const int nig = WGM * nN, gid = wgid / nig, fm = gid * WGM, gsz = (nM - fm) < WGM ? (nM - fm) : WGM;
        u.pm = fm + ((wgid % nig) % gsz); u.pn = (wgid % nig) / gsz; return true;
    }
    __device__ __forceinline__ void a_ready(const Unit&) const {}
    __device__ __forceinline__ void done(const Unit&) const {}
};

typedef float f32x2c __attribute__((ext_vector_type(2))); typedef __bf16 bf16x2c __attribute__((ext_vector_type(2)));
__device__ __forceinline__ unsigned cvt_pk_bf16(float lo, float hi) { const f32x2c v = {lo, hi}; const bf16x2c b = __builtin_convertvector(v, bf16x2c); return __builtin_bit_cast(unsigned, b); }
typedef float f32x2 __attribute__((ext_vector_type(2)));
__device__ __forceinline__ float bfl(unsigned w) { return __builtin_bit_cast(float, w << 16); }
__device__ __forceinline__ float bfh(unsigned w) { return __builtin_bit_cast(float, w & 0xffff0000u); }
__device__ __forceinline__ u32x4 pack8(const f32x4 a, const f32x4 b) { u32x4 w; w.x = cvt_pk_bf16(a[0], a[1]); w.y = cvt_pk_bf16(a[2], a[3]); w.z = cvt_pk_bf16(b[0], b[1]); w.w = cvt_pk_bf16(b[2], b[3]); return w; }

struct EpiProj {
    static constexpr bool PERM = true, PERM_A = false, SWAP = false, AFTER_DRAIN = false;
    bf16_t* O; int ldc; bf16_t* KIMG;
    __device__ __forceinline__ void operator()(const f32x4 (&acc)[2][2][4][2], const Unit& u, int wr, int wc, int fr, int fq) const {
        const int row0 = u.pm * BM + wr * 64 + fr, col0 = u.pn * BM + wc * 32 + 8 * fq;
        if (u.pn < 4) {
            const float qs = (u.pn >= 2) ? 0.125f * 1.4426950408889634f : 1.0f;
#pragma unroll
            for (int ai = 0; ai < 2; ++ai)
#pragma unroll
                for (int m = 0; m < 4; ++m) { bf16_t* rowp = O + (size_t)(row0 + ai * HALF + m * 16) * ldc + col0;
#pragma unroll
                    for (int bj = 0; bj < 2; ++bj) *(u32x4*)(rowp + bj * HALF) = pack8(acc[ai][bj][m][0] * qs, acc[ai][bj][m][1] * qs); }
        } else {
            const int slot = (wc & 1) * 4 + fq;
#pragma unroll
            for (int ai = 0; ai < 2; ++ai)
#pragma unroll
                for (int m = 0; m < 4; ++m) { const int tok = row0 + ai * HALF + m * 16, b = tok >> 12, rc = tok & 4095, cg = tok & 63;
#pragma unroll
                    for (int bj = 0; bj < 2; ++bj) { const int h = (u.pn - 4) * 4 + bj * 2 + (wc >> 1);
                        bf16_t* p = KIMG + ((((size_t)(b * 8 + h) * 4096 + rc) * 8 + (slot ^ ((cg >> 1) & 7))) * 8);
                        *(u32x4*)p = pack8(acc[ai][bj][m][0], acc[ai][bj][m][1]); } }
        }
    }
};
struct EpiVT {
    static constexpr bool PERM = false, PERM_A = true, SWAP = true, AFTER_DRAIN = false;
    bf16_t* VIMG;
    __device__ __forceinline__ void operator()(const f32x4 (&acc)[2][2][4][2], const Unit& u, int wr, int wc, int fr, int fq) const {
        const int b = u.pm >> 4, t0 = (u.pm & 15) * 256 + wr * 64 + 8 * fq, c0 = u.pn * BM + wc * 32 + fr;
#pragma unroll
        for (int bj = 0; bj < 2; ++bj)
#pragma unroll
            for (int n = 0; n < 2; ++n) { const int c = c0 + bj * HALF + n * 16, h = c >> 6, dh = c & 63;
#pragma unroll
                for (int ai = 0; ai < 2; ++ai)
#pragma unroll
                    for (int mp = 0; mp < 2; ++mp) { const int t = t0 + ai * HALF + mp * 32, rowcb = t >> 3;
                        bf16_t* p = VIMG + (((size_t)(b * 8 + h) * 512 + rowcb) * 64 + (dh ^ (4 * (rowcb & 1)))) * 8;
                        *(u32x4*)p = pack8(acc[ai][bj][2 * mp][n], acc[ai][bj][2 * mp + 1][n]); } }
    }
};
struct EpiRes1 {
    static constexpr bool PERM = true, PERM_A = false, SWAP = false, AFTER_DRAIN = false;
    const float* X; bf16_t* X1B; float* SSQ;
    __device__ __forceinline__ void operator()(const f32x4 (&acc)[2][2][4][2], const Unit& u, int wr, int wc, int fr, int fq) const {
        const int row0 = u.pm * BM + wr * 64 + fr, col0 = u.pn * BM + wc * 32 + 8 * fq;
#pragma unroll
        for (int ai = 0; ai < 2; ++ai)
#pragma unroll
            for (int m = 0; m < 4; ++m) { const int row = row0 + ai * HALF + m * 16; const size_t off = (size_t)row * 1024 + col0; float ss = 0.f;
#pragma unroll
                for (int bj = 0; bj < 2; ++bj) { const f32x4 xa = *(const f32x4*)(X + off + bj * HALF), xb = *(const f32x4*)(X + off + bj * HALF + 4);
                    const f32x4 v0 = acc[ai][bj][m][0] + xa, v1 = acc[ai][bj][m][1] + xb;
                    *(u32x4*)(X1B + off + bj * HALF) = pack8(v0, v1);
                    ss += (v0[0] * v0[0] + v0[1] * v0[1]) + (v0[2] * v0[2] + v0[3] * v0[3]) + (v1[0] * v1[0] + v1[1] * v1[1]) + (v1[2] * v1[2] + v1[3] * v1[3]); }
                ss += __shfl_xor(ss, 16); ss += __shfl_xor(ss, 32);
                if (fq == 0) SSQ[(size_t)row * 16 + u.pn * 4 + wc] = ss; }
    }
};
struct EpiRes1N {
    static constexpr bool PERM = true, PERM_A = false, SWAP = false, AFTER_DRAIN = false;
    const bf16_t* XN; bf16_t* X1B; float* SSQ; const PG8_LAS float* RT; const PG8_LAS float* GT; int PM0;
    __device__ __forceinline__ void operator()(const f32x4 (&acc)[2][2][4][2], const Unit& u, int wr, int wc, int fr, int fq) const {
        const int row0 = u.pm * BM + wr * 64 + fr, col0 = u.pn * BM + wc * 32 + 8 * fq;
        const PG8_LAS float* rt = RT + ((u.pm == PM0) ? 0 : 256) + wr * 64 + fr;
        float ri[8]; f32x4 gi[2][2];
#pragma unroll
        for (int k = 0; k < 8; ++k) ri[k] = rt[(k >> 2) * HALF + (k & 3) * 16];
#pragma unroll
        for (int bj = 0; bj < 2; ++bj) { gi[bj][0] = *(const PG8_LAS f32x4*)(GT + col0 + bj * HALF); gi[bj][1] = *(const PG8_LAS f32x4*)(GT + col0 + bj * HALF + 4); }
        __builtin_amdgcn_sched_barrier(0);
#pragma unroll
        for (int ai = 0; ai < 2; ++ai)
#pragma unroll
            for (int m = 0; m < 4; ++m) { const int row = row0 + ai * HALF + m * 16; const size_t off = (size_t)row * 1024 + col0; float ss = 0.f; const float rinv = ri[ai * 4 + m];
#pragma unroll
                for (int bj = 0; bj < 2; ++bj) { const u32x4 xw = *(const u32x4*)(XN + off + bj * HALF);
                    const f32x4 xa = (f32x4){bfl(xw.x), bfh(xw.x), bfl(xw.y), bfh(xw.y)} * rinv * gi[bj][0], xb = (f32x4){bfl(xw.z), bfh(xw.z), bfl(xw.w), bfh(xw.w)} * rinv * gi[bj][1];
                    const f32x4 v0 = acc[ai][bj][m][0] + xa, v1 = acc[ai][bj][m][1] + xb;
                    *(u32x4*)(X1B + off + bj * HALF) = pack8(v0, v1);
                    ss += (v0[0] * v0[0] + v0[1] * v0[1]) + (v0[2] * v0[2] + v0[3] * v0[3]) + (v1[0] * v1[0] + v1[1] * v1[1]) + (v1[2] * v1[2] + v1[3] * v1[3]); }
                ss += __shfl_xor(ss, 16); ss += __shfl_xor(ss, 32);
                if (fq == 0) SSQ[(size_t)row * 16 + u.pn * 4 + wc] = ss; }
    }
};
struct EpiUp {
    static constexpr bool PERM = true, PERM_A = false, SWAP = false, AFTER_DRAIN = false;
    static constexpr int HP = 4096 + 64;
    bf16_t* H; const float* SSQ; const PG8_LAS float* RL; int PM0;
    __device__ __forceinline__ void operator()(const f32x4 (&acc)[2][2][4][2], const Unit& u, int wr, int wc, int fr, int fq) const {
        const int row0 = u.pm * BM + wr * 64 + fr, col0 = u.pn * BM + wc * 32 + 8 * fq;
        const PG8_LAS float* rl = RL + ((u.pm == PM0) ? 0 : 256) + wr * 64 + fr;
#pragma unroll
        for (int ai = 0; ai < 2; ++ai)
#pragma unroll
            for (int m = 0; m < 4; ++m) { const int row = row0 + ai * HALF + m * 16; float r;
                if (PM0 >= 0) r = rl[ai * HALF + m * 16];
                else { const f32x4* sp = (const f32x4*)(SSQ + (size_t)row * 16); const f32x4 p = (sp[0] + sp[1]) + (sp[2] + sp[3]); r = __builtin_amdgcn_rsqf(((p[0] + p[1]) + (p[2] + p[3])) * (1.0f / 1024.0f) + 1e-6f); }
                bf16_t* rowp = H + (size_t)row * HP + col0;
#pragma unroll
                for (int bj = 0; bj < 2; ++bj) { f32x4 v0 = acc[ai][bj][m][0] * r, v1 = acc[ai][bj][m][1] * r;
#pragma unroll
                    for (int e = 0; e < 4; ++e) { const float a = fmaxf(v0[e], 0.f), c = fmaxf(v1[e], 0.f); v0[e] = a * a; v1[e] = c * c; }
                    *(u32x4*)(rowp + bj * HALF) = pack8(v0, v1); } }
    }
};
struct EpiRes2 {
    static constexpr bool PERM = true, PERM_A = false, SWAP = false, AFTER_DRAIN = false;
    bf16_t* X1B; float* SSQ;
    __device__ __forceinline__ void operator()(const f32x4 (&acc)[2][2][4][2], const Unit& u, int wr, int wc, int fr, int fq) const {
        const int row0 = u.pm * BM + wr * 64 + fr, col0 = u.pn * BM + wc * 32 + 8 * fq;
#pragma unroll
        for (int ai = 0; ai < 2; ++ai)
#pragma unroll
            for (int m = 0; m < 4; ++m) { const int row = row0 + ai * HALF + m * 16; const size_t off = (size_t)row * 1024 + col0; float ss = 0.f;
#pragma unroll
                for (int bj = 0; bj < 2; ++bj) { const u32x4 xw = *(const u32x4*)(X1B + off + bj * HALF);
                    const f32x4 xa = {bfl(xw.x), bfh(xw.x), bfl(xw.y), bfh(xw.y)}, xb = {bfl(xw.z), bfh(xw.z), bfl(xw.w), bfh(xw.w)};
                    const f32x4 v0 = acc[ai][bj][m][0] + xa, v1 = acc[ai][bj][m][1] + xb;
                    *(u32x4*)(X1B + off + bj * HALF) = pack8(v0, v1);
                    ss += (v0[0] * v0[0] + v0[1] * v0[1]) + (v0[2] * v0[2] + v0[3] * v0[3]) + (v1[0] * v1[0] + v1[1] * v1[1]) + (v1[2] * v1[2] + v1[3] * v1[3]); }
                ss += __shfl_xor(ss, 16); ss += __shfl_xor(ss, 32);
                if (fq == 0) SSQ[(size_t)row * 16 + u.pn * 4 + wc] = ss; }
    }
};

struct EpiY {
    static constexpr bool PERM = true, PERM_A = false, SWAP = false, AFTER_DRAIN = false;
    bf16_t* Y;
    __device__ __forceinline__ void operator()(const f32x4 (&acc)[2][2][4][2], const Unit& u, int wr, int wc, int fr, int fq) const {
        const int row0 = u.pm * BM + wr * 64 + fr, col0 = u.pn * BM + wc * 32 + 8 * fq;
#pragma unroll
        for (int ai = 0; ai < 2; ++ai)
#pragma unroll
            for (int m = 0; m < 4; ++m) { bf16_t* rowp = Y + (size_t)(row0 + ai * HALF + m * 16) * 1024 + col0;
#pragma unroll
                for (int bj = 0; bj < 2; ++bj) *(u32x4*)(rowp + bj * HALF) = pack8(acc[ai][bj][m][0], acc[ai][bj][m][1]); }
    }
};
template <class Epi, class Sched, bool ALIGN_EPI = false, bool SP2 = false>
__device__ __forceinline__ void gemm_phase(PG8_LAS unsigned char* lds, const Gemm g, const Sched& S, const Epi& E) {
    const int tid = threadIdx.x, wid = __builtin_amdgcn_readfirstlane(tid >> 6), lane = tid & 63, wr = wid >> 2, wc = wid & 3, fr = lane & 15, fq = lane >> 4;
    const int K = g.K, nt = K / BK;
    unsigned voffA[2], voffB[2];
#pragma unroll
    for (int i = 0; i < 2; ++i) { int R, C; stage_rc(tid * 16 + i * 8192, R, C); const int Rb = Epi::PERM ? ((R & ~31) + perm32(R & 31)) : R; const int Ra = Epi::PERM_A ? ((R & ~31) + perm32(R & 31)) : R;
        voffA[i] = (unsigned)(Ra * g.lda + C) * 2u; voffB[i] = (unsigned)(Rb * K + C) * 2u; }
    const size_t kstep = (size_t)(BK * 2);
    const size_t hstep = (size_t)HALF * K * 2;
    const size_t tstep = 2 * hstep;
    const size_t hstepA = (size_t)HALF * g.lda * 2, tstepA = 2 * hstepA;
    const unsigned ldsw = (unsigned)wid * 1024u;
    const int aoff = lds_byte(wr * 64 + fr, fq * 8), boff = lds_byte(wc * 32 + fr, fq * 8);
#define PG8_SA(b, h) (((b) * 2 + (h)) * HTB)
#define PG8_SB(b, h) ((4 + (b) * 2 + (h)) * HTB)
#define PG8_STAGE(bufoff, gbase, voff) do { _Pragma("unroll") for (int _i = 0; _i < 2; ++_i) \
        __builtin_amdgcn_global_load_lds((const unsigned*)((const char*)(gbase) + (voff)[_i]), (PG8_LAS unsigned*)(lds + (bufoff) + ldsw + _i * 8192), 16, 0, 0); } while (0)
#define PG8_LDA(dst, b, h) do { _Pragma("unroll") for (int m = 0; m < 4; ++m) _Pragma("unroll") for (int k = 0; k < 2; ++k) dst[m][k] = *(const PG8_LAS bf16x8*)(lds + PG8_SA(b, h) + aoff + m * 2048 + k * 1024); } while (0)
#define PG8_LDB(dst, b, h) do { _Pragma("unroll") for (int n = 0; n < 2; ++n) _Pragma("unroll") for (int k = 0; k < 2; ++k) dst[n][k] = *(const PG8_LAS bf16x8*)(lds + PG8_SB(b, h) + boff + n * 2048 + k * 1024); } while (0)
#define PG8_MMA(ai, bj, At, Bt) do { __builtin_amdgcn_s_setprio(1); _Pragma("unroll") for (int m = 0; m < 4; ++m) _Pragma("unroll") for (int n = 0; n < 2; ++n) _Pragma("unroll") for (int k = 0; k < 2; ++k) \
        acc[ai][bj][m][n] = Epi::SWAP ? __builtin_amdgcn_mfma_f32_16x16x32_bf16(At[m][k], Bt[n][k], acc[ai][bj][m][n], 0, 0, 0) : __builtin_amdgcn_mfma_f32_16x16x32_bf16(Bt[n][k], At[m][k], acc[ai][bj][m][n], 0, 0, 0); __builtin_amdgcn_s_setprio(0); } while (0)
#define PG8_WAIT_V(n) asm volatile("s_waitcnt vmcnt(" #n ")" ::: "memory")
#define PG8_WAIT_L(n) asm volatile("s_waitcnt lgkmcnt(" #n ")" ::: "memory")
#define PG8_BAR __builtin_amdgcn_s_barrier()
#define PG8_SCHED __builtin_amdgcn_sched_barrier(0)
    Unit cur, nxt; int ui = 0;
    if (!S.next(0, cur)) return;
    f32x4 acc[2][2][4][2];
#pragma unroll
    for (int a = 0; a < 2; ++a)
#pragma unroll
        for (int b = 0; b < 2; ++b)
#pragma unroll
            for (int m = 0; m < 4; ++m)
#pragma unroll
                for (int n = 0; n < 2; ++n) acc[a][b][m][n] = (f32x4){0.f, 0.f, 0.f, 0.f};
    bf16x8 At[4][2], B0[2][2], B1[2][2];
    const char* cA = (const char*)g.A + (size_t)cur.pm * tstepA; const char* cB = (const char*)g.Bt + (size_t)cur.pn * tstep;
    S.a_ready(cur);
    if constexpr (SP2) {
        PG8_STAGE(PG8_SB(0, 0), cB, voffB); PG8_STAGE(PG8_SB(0, 1), cB + hstep, voffB); PG8_STAGE(PG8_SA(0, 0), cA, voffA); PG8_STAGE(PG8_SA(0, 1), cA + hstepA, voffA);
        if (wr == 1) PG8_BAR;
        PG8_WAIT_V(2); PG8_BAR;
        PG8_STAGE(PG8_SB(1, 0), cB + kstep, voffB); PG8_STAGE(PG8_SA(1, 0), cA + kstep, voffA); PG8_STAGE(PG8_SB(1, 1), cB + hstep + kstep, voffB);
        PG8_WAIT_V(6); PG8_BAR;
    } else {
        PG8_STAGE(PG8_SB(0, 0), cB, voffB); PG8_STAGE(PG8_SA(0, 0), cA, voffA); PG8_STAGE(PG8_SB(0, 1), cB + hstep, voffB); PG8_STAGE(PG8_SA(0, 1), cA + hstepA, voffA);
        if (wr == 1) PG8_BAR;
        PG8_WAIT_V(4); PG8_BAR;
        PG8_STAGE(PG8_SB(1, 0), cB + kstep, voffB); PG8_STAGE(PG8_SA(1, 0), cA + kstep, voffA); PG8_STAGE(PG8_SB(1, 1), cB + hstep + kstep, voffB);
        PG8_WAIT_V(6); PG8_BAR;
    }
    for (;;) {
        const bool has_next = S.next(ui + 1, nxt);
        const char* nA = has_next ? (const char*)g.A + (size_t)nxt.pm * tstepA : cA; const char* nB = has_next ? (const char*)g.Bt + (size_t)nxt.pn * tstep : cB;
        for (int t = 0; t < nt; t += 2) {
            const bool last = (t == nt - 2);
            const char* a1 = cA + (size_t)(t + 1) * kstep;
            const char* a2 = last ? nA : cA + (size_t)(t + 2) * kstep; const char* b2 = last ? nB : cB + (size_t)(t + 2) * kstep;
            const char* a3 = a2 + kstep; const char* b3 = b2 + kstep;
            if (last && has_next) S.a_ready(nxt);
            if constexpr (SP2) {
            PG8_LDB(B0, 0, 0); PG8_LDB(B1, 0, 1); PG8_SCHED; PG8_LDA(At, 0, 0); PG8_STAGE(PG8_SA(1, 1), a1 + hstepA, voffA);
            PG8_WAIT_V(8); PG8_WAIT_L(0); PG8_BAR; PG8_MMA(0, 0, At, B0); PG8_MMA(0, 1, At, B1); PG8_BAR; PG8_SCHED;
            PG8_LDA(At, 0, 1); PG8_STAGE(PG8_SB(0, 0), b2, voffB); PG8_STAGE(PG8_SB(0, 1), b2 + hstep, voffB); PG8_STAGE(PG8_SA(0, 0), a2, voffA);
            PG8_WAIT_V(8); PG8_WAIT_L(0); PG8_BAR; PG8_MMA(1, 0, At, B0); PG8_MMA(1, 1, At, B1); PG8_BAR; PG8_SCHED;
            PG8_LDB(B0, 1, 0); PG8_LDB(B1, 1, 1); PG8_SCHED; PG8_LDA(At, 1, 0); PG8_STAGE(PG8_SA(0, 1), a2 + hstepA, voffA);
            PG8_WAIT_V(8); PG8_WAIT_L(0); PG8_BAR; PG8_MMA(0, 0, At, B0); PG8_MMA(0, 1, At, B1); PG8_BAR; PG8_SCHED;
            PG8_LDA(At, 1, 1); PG8_STAGE(PG8_SB(1, 0), b3, voffB); PG8_STAGE(PG8_SB(1, 1), b3 + hstep, voffB); PG8_STAGE(PG8_SA(1, 0), a3, voffA);
            PG8_WAIT_V(8); PG8_WAIT_L(0); PG8_BAR; PG8_MMA(1, 0, At, B0); PG8_MMA(1, 1, At, B1); PG8_BAR; PG8_SCHED;
            } else {
            PG8_LDB(B0, 0, 0); PG8_SCHED; PG8_LDA(At, 0, 0); PG8_STAGE(PG8_SA(1, 1), a1 + hstepA, voffA);
            PG8_WAIT_L(8); PG8_BAR; PG8_WAIT_L(0); PG8_MMA(0, 0, At, B0); PG8_BAR; PG8_SCHED;
            PG8_LDB(B1, 0, 1); PG8_STAGE(PG8_SB(0, 0), b2, voffB);
            PG8_BAR; PG8_WAIT_L(0); PG8_MMA(0, 1, At, B1); PG8_BAR;
            PG8_LDA(At, 0, 1); PG8_STAGE(PG8_SA(0, 0), a2, voffA);
            PG8_BAR; PG8_WAIT_L(0); PG8_MMA(1, 0, At, B0); PG8_BAR; PG8_SCHED;
            PG8_STAGE(PG8_SB(0, 1), b2 + hstep, voffB);
            PG8_WAIT_V(6); PG8_BAR; PG8_MMA(1, 1, At, B1); PG8_BAR;
            PG8_LDB(B0, 1, 0); PG8_SCHED; PG8_LDA(At, 1, 0); PG8_STAGE(PG8_SA(0, 1), a2 + hstepA, voffA);
            PG8_WAIT_L(8); PG8_BAR; PG8_WAIT_L(0); PG8_MMA(0, 0, At, B0); PG8_BAR; PG8_SCHED;
            PG8_LDB(B1, 1, 1); PG8_STAGE(PG8_SB(1, 0), b3, voffB);
            PG8_BAR; PG8_WAIT_L(0); PG8_MMA(0, 1, At, B1); PG8_BAR;
            PG8_LDA(At, 1, 1); PG8_STAGE(PG8_SA(1, 0), a3, voffA);
            PG8_BAR; PG8_WAIT_L(0); PG8_MMA(1, 0, At, B0); PG8_BAR; PG8_SCHED;
            PG8_STAGE(PG8_SB(1, 1), b3 + hstep, voffB);
            PG8_WAIT_V(6); PG8_BAR; PG8_MMA(1, 1, At, B1); PG8_BAR;
            }
        }
        if constexpr (ALIGN_EPI) { if (wr == 0) PG8_BAR; }
        if constexpr (!Epi::AFTER_DRAIN) { E(acc, cur, wr, wc, fr, fq); S.done(cur); }
        if (!has_next) break;
#pragma unroll
        for (int a = 0; a < 2; ++a)
#pragma unroll
            for (int b = 0; b < 2; ++b)
#pragma unroll
                for (int m = 0; m < 4; ++m)
#pragma unroll
                    for (int n = 0; n < 2; ++n) acc[a][b][m][n] = (f32x4){0.f, 0.f, 0.f, 0.f};
        cur = nxt; cA = nA; cB = nB; ++ui;
        if constexpr (ALIGN_EPI) { if (wr == 1) PG8_BAR; }
    }
    PG8_WAIT_V(0);
    if constexpr (!ALIGN_EPI) { if (wr == 0) PG8_BAR; }
    PG8_BAR;
    if constexpr (Epi::AFTER_DRAIN) { E.fused(acc, cur, wr, wc, fr, fq, lds, wid, lane); S.done(cur); }
#undef PG8_SA
#undef PG8_SB
#undef PG8_STAGE
#undef PG8_LDA
#undef PG8_LDB
#undef PG8_MMA
#undef PG8_WAIT_V
#undef PG8_WAIT_L
#undef PG8_BAR
#undef PG8_SCHED
}
}
#ifndef MK_N_LAUNCHES
#define MK_N_LAUNCHES 1
#endif
constexpr int N_PHASES = 7;
constexpr int NWAVES = 8;
constexpr int M = 32768, D = 1024, FF = 4096, NPROJ = 1536, T = 4096;
constexpr size_t MiB = 1u << 20;
constexpr size_t WS_WIN = 0, WS_WOUT = 4 * MiB, WS_WUP = 6 * MiB, WS_WDOWN = 14 * MiB, WS_WPOOL = 22 * MiB, WS_SSQ = 23 * MiB;
constexpr size_t WS_X1B = 32 * MiB, WS_H = 96 * MiB, WS_XN = 96 * MiB, WS_PROJ = 160 * MiB, WS_VT = 256 * MiB, WS_CAT = 288 * MiB, WS_Y = 360 * MiB, WS_END = 424 * MiB;
constexpr int LDS_MISC = 149504, LDS_BYTES = 149504 + 64;
constexpr size_t WS_CTL = 26 * MiB, CTL_BYTES = 16384, WS_RSTD = 30 * MiB;
#define LAS __attribute__((address_space(3)))
typedef unsigned short bf16_t;
typedef short bf16x8 __attribute__((ext_vector_type(8)));
typedef float f32x4 __attribute__((ext_vector_type(4)));
typedef unsigned u32x4 __attribute__((ext_vector_type(4)));
typedef unsigned u32x2 __attribute__((ext_vector_type(2)));
#define LDS_WAIT() asm volatile("s_waitcnt lgkmcnt(0)" ::: "memory")
using pg8::cvt_pk_bf16;
__device__ __forceinline__ float wave_sum(float v) {
#pragma unroll
    for (int o = 1; o < 64; o <<= 1) v += __shfl_xor(v, o);
    return v;
}
__device__ __forceinline__ float bf_lo(unsigned w) { return __builtin_bit_cast(float, w << 16); }
__device__ __forceinline__ float bf_hi(unsigned w) { return __builtin_bit_cast(float, w & 0xffff0000u); }

__device__ __forceinline__ void p0_transpose_item(const float* W, int K, int N, bf16_t* WT, const float* kscale, const float* nscale, LAS float* scr, int item, int lane) {
    const int nblk = N / 32, kb = item / nblk, nb = item % nblk, k0 = 64 * kb, n0 = 32 * nb;
    const float ns = nscale ? nscale[n0 + (lane & 31)] : 1.f;
#pragma unroll 8
    for (int i = 0; i < 32; ++i) { const int kk = 2 * i + (lane >> 5); float w = W[(size_t)(k0 + kk) * N + n0 + (lane & 31)]; if (kscale) w *= kscale[k0 + kk]; scr[kk * 33 + (lane & 31)] = w * ns; }
    LDS_WAIT(); asm volatile("" ::: "memory");
    const int c = lane & 7;
#pragma unroll
    for (int j = 0; j < 4; ++j) { const int n = (lane >> 3) + 8 * j; const LAS float* s = scr + (8 * c) * 33 + n;
        u32x4 o; o.x = cvt_pk_bf16(s[0 * 33], s[1 * 33]); o.y = cvt_pk_bf16(s[2 * 33], s[3 * 33]); o.z = cvt_pk_bf16(s[4 * 33], s[5 * 33]); o.w = cvt_pk_bf16(s[6 * 33], s[7 * 33]);
        *(u32x4*)(WT + (size_t)(n0 + n) * K + k0 + 8 * c) = o; }
    LDS_WAIT(); asm volatile("" ::: "memory");
}

struct Args { const float* in[11]; float* out; unsigned char* ws; int lo, hi; };

constexpr float LOG2E = 1.4426950408889634f;
constexpr int A_K = 0, A_V = 73728, A_TBL = 147456;
#define ATT_BAR() do { asm volatile("s_waitcnt lgkmcnt(0)" ::: "memory"); __builtin_amdgcn_s_barrier(); asm volatile("" ::: "memory"); } while (0)
#define ATT_GLDS(gp, ldsoff) __builtin_amdgcn_global_load_lds((const unsigned*)(gp), (LAS unsigned*)(lds + (ldsoff)), 16, 0, 0)
__device__ __forceinline__ void attn_phase(LAS unsigned char* lds, const bf16_t* __restrict__ PROJ, const bf16_t* __restrict__ KIMG, const bf16_t* __restrict__ VIMG, bf16_t* __restrict__ CAT, const float* __restrict__ rpb,
                                           int vcu, int G, int tid, int lane, int wave, bool first_dma_issued) {
    const int qi = lane & 15, g = lane >> 4, rr = wave >> 2, j = wave & 3;
    const int bs = (j == 0) ? 0 : ((j == 3) ? 32 : 16 * j - 8);
    const int qcol = 16 * j + qi, qc0 = min(max(qcol - 8, 0), 48);
    int idx[8];
#pragma unroll
    for (int jj = 0; jj < 8; ++jj) { const int kc = bs + 8 * g + jj; const bool ok = (kc >= qc0) && (kc < qc0 + 16); idx[jj] = ok ? (kc - qcol + 15) : 31; }
    unsigned koff[2][2], voff[4];
#pragma unroll
    for (int tt = 0; tt < 2; ++tt)
#pragma unroll
        for (int ks = 0; ks < 2; ++ks) { const int key = bs + 8 * (qi >> 2) + (qi & 3) + 4 * tt; koff[tt][ks] = (unsigned)(key * 128 + (((2 * g + ks) ^ ((key >> 1) & 7)) * 16)); }
#pragma unroll
    for (int nt = 0; nt < 4; ++nt) { const int cb = (bs >> 3) + g, dh = 32 * (nt >> 1) + 8 * (qi >> 2) + 4 * (nt & 1) + (qi & 3); voff[nt] = (unsigned)(cb * 1024 + ((dh ^ (4 * (cb & 1))) * 16)); }
    LAS float* tbl = (LAS float*)(lds + A_TBL);
    const unsigned dmaoff = (unsigned)wave * 1024u;
    for (int wu = vcu; wu < 256; wu += G) {
        const int bh = wu >> 2, s0 = (wu & 3) * 8, b = bh >> 3, h = bh & 7;
        const char* kimg = (const char*)KIMG + (size_t)bh * (64 * 8192) + tid * 16;
        const char* vimg = (const char*)VIMG + (size_t)bh * (64 * 8192) + tid * 16;
        const bf16_t* qbase = PROJ + ((size_t)b * T + qcol) * NPROJ + 512 + h * 64 + 16 * g;
        if (!(first_dma_issued && wu == vcu)) ATT_BAR();
        { const int row = tid >> 5, c = tid & 31; tbl[tid] = (row < 15 && c < 31) ? rpb[(h * 15 + row) * 31 + c] * LOG2E : -INFINITY; }
        int krlo = min(max(2 * s0 - 4, 0), 55);
        if (!(first_dma_issued && wu == vcu)) {
#pragma unroll
        for (int ii = 0; ii < 9; ++ii) { const int row = krlo + ii, slot = row % 9; ATT_GLDS(kimg + (size_t)row * 8192, A_K + slot * 8192 + dmaoff); ATT_GLDS(vimg + (size_t)row * 8192, A_V + slot * 8192 + dmaoff); }
        }
        bf16x8 qf0, qf1;
        { const bf16_t* qp = qbase + (size_t)((2 * s0 + rr) * 64) * NPROJ; qf0 = *(const bf16x8*)qp; qf1 = *(const bf16x8*)(qp + 8); }
        unsigned bpk[9][4]; int bkey = -1000;
        asm volatile("s_waitcnt vmcnt(0)" ::: "memory");
        asm volatile("" : "+v"(qf0), "+v"(qf1));
        ATT_BAR();
        for (int st = 0; st < 8; ++st) {
            const int s = s0 + st, r = 2 * s + rr, r0 = min(max(r - 4, 0), 56);
            int sl0 = krlo % 9;
            { const int key = (krlo - r) * 64 + (r0 - r);
              if (key != bkey) { bkey = key;
#pragma unroll
                for (int ii = 0; ii < 9; ++ii) { const int kr = krlo + ii; const int trow = ((kr >= r0) && (kr <= r0 + 7)) ? (kr - r + 7) : 15; const LAS float* tp = tbl + trow * 32;
#pragma unroll
                    for (int pp = 0; pp < 4; ++pp) bpk[ii][pp] = pg8::cvt_pk_bf16(tp[idx[2 * pp]], tp[idx[2 * pp + 1]]); } } }
            f32x4 sc[9][2];
            { int sl = sl0;
              bf16x8 kb[2][2][2];
#define ATT_LOADK(ii_, buf_) do { const unsigned base_ = (unsigned)(A_K + sl * 8192); \
                _Pragma("unroll") for (int tt = 0; tt < 2; ++tt) { kb[buf_][tt][0] = *(const LAS bf16x8*)(lds + base_ + koff[tt][0]); kb[buf_][tt][1] = *(const LAS bf16x8*)(lds + base_ + koff[tt][1]); } \
                sl = (sl == 8) ? 0 : sl + 1; } while (0)
              ATT_LOADK(0, 0);
#pragma unroll
              for (int ii = 0; ii < 9; ++ii) {
                if (ii < 8) ATT_LOADK(ii + 1, (ii + 1) & 1);
                __builtin_amdgcn_sched_barrier(0);
#pragma unroll
                for (int tt = 0; tt < 2; ++tt) { f32x4 a = {bf_lo(bpk[ii][2 * tt]), bf_hi(bpk[ii][2 * tt]), bf_lo(bpk[ii][2 * tt + 1]), bf_hi(bpk[ii][2 * tt + 1])};
                    a = __builtin_amdgcn_mfma_f32_16x16x32_bf16(kb[ii & 1][tt][0], qf0, a, 0, 0, 0);
                    a = __builtin_amdgcn_mfma_f32_16x16x32_bf16(kb[ii & 1][tt][1], qf1, a, 0, 0, 0);
                    sc[ii][tt] = a; }
                __builtin_amdgcn_sched_barrier(0);
              }
#undef ATT_LOADK
            }
            ATT_BAR();
            const int sn = min(s + 1, 31), krn = min(max(2 * sn - 4, 0), 55);
            { const int ra = krn + 7, rb = krn + 8; ATT_GLDS(kimg + (size_t)ra * 8192, A_K + (ra % 9) * 8192 + dmaoff); ATT_GLDS(kimg + (size_t)rb * 8192, A_K + (rb % 9) * 8192 + dmaoff); }
            bf16x8 qn0, qn1;
            { const bf16_t* qp = qbase + (size_t)((2 * sn + rr) * 64) * NPROJ; qn0 = *(const bf16x8*)qp; qn1 = *(const bf16x8*)(qp + 8); }
            float mx = -INFINITY;
#pragma unroll
            for (int ii = 0; ii < 9; ++ii)
#pragma unroll
                for (int jj = 0; jj < 8; ++jj) mx = fmaxf(mx, sc[ii][jj >> 2][jj & 3]);
            mx = fmaxf(mx, __shfl_xor(mx, 16)); mx = fmaxf(mx, __shfl_xor(mx, 32));
            float sum = 0.f;
            bf16x8 pf[9];
#pragma unroll
            for (int ii = 0; ii < 9; ++ii) {
#pragma unroll
                for (int jj = 0; jj < 8; ++jj) { const float p = __builtin_amdgcn_exp2f(sc[ii][jj >> 2][jj & 3] - mx); sc[ii][jj >> 2][jj & 3] = p; sum += p; }
                const u32x4 w = pg8::pack8(sc[ii][0], sc[ii][1]); pf[ii] = __builtin_bit_cast(bf16x8, w); }
            sum += __shfl_xor(sum, 16); sum += __shfl_xor(sum, 32);
            const float inv = 1.0f / sum;
            asm volatile("s_waitcnt vmcnt(4)" ::: "memory");
            ATT_BAR();
            f32x4 o[4];
#pragma unroll
            for (int nt = 0; nt < 4; ++nt) o[nt] = (f32x4){0.f, 0.f, 0.f, 0.f};
            { int sl = sl0;
              bf16x8 vb[2][4];
#define ATT_LOADV(buf_) do { const unsigned base_ = (unsigned)(A_V + sl * 8192); _Pragma("unroll") for (int nt = 0; nt < 4; ++nt) vb[buf_][nt] = *(const LAS bf16x8*)(lds + base_ + voff[nt]); sl = (sl == 8) ? 0 : sl + 1; } while (0)
              ATT_LOADV(0);
#pragma unroll
              for (int ii = 0; ii < 9; ++ii) {
                if (ii < 8) ATT_LOADV((ii + 1) & 1);
                __builtin_amdgcn_sched_barrier(0);
#pragma unroll
                for (int nt = 0; nt < 4; ++nt) o[nt] = __builtin_amdgcn_mfma_f32_16x16x32_bf16(vb[ii & 1][nt], pf[ii], o[nt], 0, 0, 0);
                __builtin_amdgcn_sched_barrier(0);
              }
#undef ATT_LOADV
            }
            ATT_BAR();
            asm volatile("s_waitcnt vmcnt(0)" ::: "memory");
            asm volatile("" : "+v"(qn0), "+v"(qn1));
            qf0 = qn0; qf1 = qn1;
            { const int ra = krn + 7, rb = krn + 8; ATT_GLDS(vimg + (size_t)ra * 8192, A_V + (ra % 9) * 8192 + dmaoff); ATT_GLDS(vimg + (size_t)rb * 8192, A_V + (rb % 9) * 8192 + dmaoff); }
            bf16_t* op = CAT + ((size_t)b * T + r * 64 + qcol) * 1024 + 512 + h * 64 + 8 * g;
            *(u32x4*)op = pg8::pack8(o[0] * inv, o[1] * inv);
            *(u32x4*)(op + 32) = pg8::pack8(o[2] * inv, o[3] * inv);
            ATT_BAR();
            krlo = krn;
        }
        asm volatile("s_waitcnt vmcnt(0)" ::: "memory");
    }
    ATT_BAR();
}

__device__ __forceinline__ void pool_wave_group(const bf16_t* __restrict__ PROJ, const bf16_t* __restrict__ WPT, bf16_t* __restrict__ CAT, int gi, int tile_first, int tile_step, int lane) {
    const int qi = lane & 15, g = lane >> 4;
    const int w = 2 << gi, half = w >> 1;
    const unsigned ulane = (unsigned)((8 * (qi >> 2) + (qi & 3)) * NPROJ + 8 * g) * 2u;
    const char* wbase = (const char*)(WPT + (size_t)gi * 16384);
    const unsigned wlane = (unsigned)((8 * (qi >> 2) + (qi & 3)) * 128 + 8 * g) * 2u;
    bf16x8 wf[4][2][4];
#pragma unroll
    for (int np = 0; np < 4; ++np)
#pragma unroll
        for (int e = 0; e < 2; ++e)
#pragma unroll
            for (int ks = 0; ks < 4; ++ks) wf[np][e][ks] = *(const bf16x8*)(wbase + ((32 * np + 4 * e) * 128 + 32 * ks) * 2 + wlane);
    bf16x8 ua[4], ub[4];
    if (tile_first < M / 16) {
        const char* ubase = (const char*)(PROJ + ((long)tile_first * 16 - 8) * NPROJ + gi * 128);
#pragma unroll
        for (int ks = 0; ks < 4; ++ks) { ua[ks] = *(const bf16x8*)(ubase + ks * 64 + ulane); ub[ks] = *(const bf16x8*)(ubase + 4 * NPROJ * 2 + ks * 64 + ulane); }
    }
    for (int tile16 = tile_first; tile16 < M / 16; tile16 += tile_step) {
        bf16x8 ca[4], cb[4];
#pragma unroll
        for (int ks = 0; ks < 4; ++ks) { ca[ks] = ua[ks]; cb[ks] = ub[ks]; }
        { const int tn = (tile16 + tile_step < M / 16) ? tile16 + tile_step : tile16;
          const char* ubase = (const char*)(PROJ + ((long)tn * 16 - 8) * NPROJ + gi * 128);
#pragma unroll
          for (int ks = 0; ks < 4; ++ks) { ua[ks] = *(const bf16x8*)(ubase + ks * 64 + ulane); ub[ks] = *(const bf16x8*)(ubase + 4 * NPROJ * 2 + ks * 64 + ulane); } }
        const int t0 = (tile16 * 16) & (T - 1);
        const int tq = t0 + qi, lo = max(tq - half, 0), hi = min(tq - half + w, T);
        const float invn = 1.0f / (float)(hi - lo);
        float pv[8];
#pragma unroll
        for (int jj = 0; jj < 8; ++jj) { const int tp = t0 - 8 + 8 * g + jj; pv[jj] = ((tp >= lo && tp < hi) ? invn : 0.f) - ((tp == tq) ? 1.f : 0.f); }
        const u32x4 pmw = pg8::pack8((f32x4){pv[0], pv[1], pv[2], pv[3]}, (f32x4){pv[4], pv[5], pv[6], pv[7]});
        const bf16x8 pm = __builtin_bit_cast(bf16x8, pmw);
        __builtin_amdgcn_sched_barrier(0);
        bf16_t* op = CAT + ((size_t)tile16 * 16 + qi) * 1024 + gi * 128 + 8 * g;
#pragma unroll
        for (int np = 0; np < 4; ++np) {
            f32x4 c[2];
#pragma unroll
            for (int e = 0; e < 2; ++e) {
                f32x4 za = {0.f, 0.f, 0.f, 0.f}, zb = {0.f, 0.f, 0.f, 0.f};
#pragma unroll
                for (int ks = 0; ks < 4; ++ks) { za = __builtin_amdgcn_mfma_f32_16x16x32_bf16(ca[ks], wf[np][e][ks], za, 0, 0, 0); zb = __builtin_amdgcn_mfma_f32_16x16x32_bf16(cb[ks], wf[np][e][ks], zb, 0, 0, 0); }
                const u32x4 zw = pg8::pack8(za, zb);
                c[e] = __builtin_amdgcn_mfma_f32_16x16x32_bf16(__builtin_bit_cast(bf16x8, zw), pm, (f32x4){0.f, 0.f, 0.f, 0.f}, 0, 0, 0);
            }
            *(u32x4*)(op + 32 * np) = pg8::pack8(c[0], c[1]);
        }
    }
}

typedef __attribute__((address_space(1))) unsigned gu32;
#define RLX_AGENT __ATOMIC_RELAXED, __HIP_MEMORY_SCOPE_AGENT
#define XB_TMO      128
#define XB_XCNT(j)  (256  + 64 * (j))
#define XB_XSUB(j)  (1280 + 64 * (j))
#define XB_XGEN(j)  (2304 + 64 * (j))
#define XB_TOP      3328
#define XB_TOPGEN   3392
#define XCD_BAR_WORDS 3456
#define XB_SPIN_CAP (1u << 18)

__device__ __forceinline__ unsigned xb_ld(unsigned* p)              { return __hip_atomic_load(p, __ATOMIC_RELAXED, __HIP_MEMORY_SCOPE_AGENT); }
__device__ __forceinline__ unsigned xb_add(unsigned* p, unsigned v) { return __hip_atomic_fetch_add(p, v, __ATOMIC_RELAXED, __HIP_MEMORY_SCOPE_AGENT); }
__device__ __forceinline__ unsigned xb_xcc_id() { return (unsigned)__builtin_amdgcn_s_getreg((3 << 11) | 20) & 0xFu; }
#define XB_SPIN(cond, bar) do { unsigned _sp = 0; while (cond) { __builtin_amdgcn_s_sleep(1); \
    if ((++_sp & 255u) == 0u) { if (xb_ld(&(bar)[XB_TMO])) break; if (_sp > XB_SPIN_CAP) { atomicAdd(&(bar)[XB_TMO], 1u); break; } } } } while (0)

struct XcdBarrier {
    unsigned* bar; unsigned x;
    volatile LAS unsigned* st;
};

__device__ __forceinline__ XcdBarrier xcd_barrier_post(unsigned* bar, volatile LAS unsigned* st) {
    XcdBarrier b; b.bar = bar; b.x = xb_xcc_id(); b.st = st;
    if (threadIdx.x == 0) (void)xb_add(&bar[XB_XCNT(b.x)], 1u);
    return b;
}
__device__ __forceinline__ void xcd_barrier_complete(unsigned* bar, unsigned x, unsigned& nloc, unsigned& nx) {
    const unsigned G = gridDim.x * gridDim.y * gridDim.z;
    unsigned sum, cnt, mine, sp = 0u;
    for (;;) {
        sum = 0u; cnt = 0u; mine = 0u;
#pragma unroll
        for (unsigned j = 0; j < 16; ++j) { const unsigned c = xb_ld(&bar[XB_XCNT(j)]); sum += c; cnt += (c > 0u) ? 1u : 0u; mine = (j == x) ? c : mine; }
        if (sum == G) break;
        __builtin_amdgcn_s_sleep(1);
        if ((++sp & 255u) == 0u) { if (xb_ld(&bar[XB_TMO])) break; if (sp > XB_SPIN_CAP) { atomicAdd(&bar[XB_TMO], 1u); break; } }
    }
    nloc = mine > 0u ? mine : 1u; nx = cnt > 0u ? cnt : 1u;
}

__device__ __forceinline__ void xcd_barrier(const XcdBarrier& b) {
    asm volatile("s_waitcnt vmcnt(0)" ::: "memory");
    __syncthreads();
    if (threadIdx.x == 0) {
        unsigned* bar = b.bar;
        __builtin_amdgcn_s_waitcnt(0);
        unsigned nloc = b.st[0], nx = b.st[1];
        if (nloc == 0u) { xcd_barrier_complete(bar, b.x, nloc, nx); b.st[0] = nloc; b.st[1] = nx; }
        const unsigned old = xb_add(&bar[XB_XSUB(b.x)], 1u);
        const unsigned gen = old / nloc;
        if (old + 1u == (gen + 1u) * nloc) {
            __builtin_amdgcn_fence(__ATOMIC_RELEASE, "agent");
            asm volatile("s_waitcnt vmcnt(0)" ::: "memory");
            const unsigned og = xb_add(&bar[XB_TOP], 1u);
            const unsigned tg = og / nx;
            if (og + 1u == (tg + 1u) * nx) xb_add(&bar[XB_TOPGEN], 1u);
            else XB_SPIN(xb_ld(&bar[XB_TOPGEN]) == tg, bar);
            __builtin_amdgcn_fence(__ATOMIC_ACQUIRE, "agent");
            xb_add(&bar[XB_XGEN(b.x)], 1u);
            asm volatile("s_waitcnt vmcnt(0)" ::: "memory");
        } else {
            XB_SPIN(xb_ld(&bar[XB_XGEN(b.x)]) == gen, bar);
            __builtin_amdgcn_fence(__ATOMIC_ACQUIRE, "agent");
            asm volatile("s_waitcnt vmcnt(0)" ::: "memory");
        }
    }
    __syncthreads();
}

__global__ void __launch_bounds__(NWAVES * 64, 2) mk_fwd(Args args) {
    extern __shared__ __attribute__((aligned(16))) unsigned char lds_raw[];
    LAS unsigned char* lds = (LAS unsigned char*)lds_raw;
    const int tid = threadIdx.x, lane = tid & 63, wave = __builtin_amdgcn_readfirstlane(tid >> 6);
    const int G = gridDim.x, bx = blockIdx.x;
    const int vcu = (G % 8 == 0) ? (bx % 8) * (G / 8) + bx / 8 : bx;
    const int gw = vcu * NWAVES + wave, NGW = G * NWAVES;
    unsigned char* ws = args.ws;
    const float* x = args.in[0]; const float* g1 = args.in[1]; const float* w_in = args.in[2]; const float* w_pool = args.in[3]; const float* pool_scale = args.in[4];
    const float* rpb = args.in[5]; const float* w_out = args.in[6]; const float* g2 = args.in[7]; const float* w_up = args.in[8]; const float* w_down = args.in[9]; const float* gf = args.in[10];
    float* out = args.out;
    bf16_t* WIN_T = (bf16_t*)(ws + WS_WIN); bf16_t* WOUT_T = (bf16_t*)(ws + WS_WOUT); bf16_t* WUP_T = (bf16_t*)(ws + WS_WUP); bf16_t* WDOWN_T = (bf16_t*)(ws + WS_WDOWN); bf16_t* WPOOL_T = (bf16_t*)(ws + WS_WPOOL);
    float* SSQ = (float*)(ws + WS_SSQ); float* RSTD1 = (float*)(ws + WS_RSTD);
    bf16_t* X1B = (bf16_t*)(ws + WS_X1B); bf16_t* HB = (bf16_t*)(ws + WS_H); bf16_t* XN = (bf16_t*)(ws + WS_XN); bf16_t* PROJ = (bf16_t*)(ws + WS_PROJ); bf16_t* VT = (bf16_t*)(ws + WS_VT); bf16_t* KIMG = (bf16_t*)(ws + WS_X1B); bf16_t* CAT = (bf16_t*)(ws + WS_CAT);
    const int lo = args.lo, hi = args.hi;
#define IN(k) (lo <= (k) && (k) < hi)
#ifndef DUP_PHASE
#define DUP_PHASE -1
#endif
#define REP(k) for (int rep_ = 0; rep_ < ((k) == DUP_PHASE ? 2 : 1); ++rep_)
#define SEAM(k) do { if (IN(k) && IN((k) + 1)) xcd_barrier(bar); } while (0)
    volatile LAS unsigned* misc = (volatile LAS unsigned*)(lds + LDS_MISC);
    if (tid < 16) misc[tid] = 0u;
    __syncthreads();
    XcdBarrier bar; bar.bar = (unsigned*)(ws + WS_CTL); bar.x = 0; bar.st = nullptr;
    if (hi - lo > 1) bar = xcd_barrier_post((unsigned*)(ws + WS_CTL), misc);
    if (lo > N_PHASES) cg::this_grid().sync();

    if (IN(0)) REP(0) {
        LAS float* scr = (LAS float*)(lds + wave * 16384);
        constexpr int I_IN = (D / 64) * (2048 / 32), I_OUT = (D / 64) * (D / 32), I_UP = (D / 64) * (FF / 32), I_DN = (FF / 64) * (D / 32), I_PL = 2 * 4;
        constexpr int NITEMS = I_IN + I_OUT + I_UP + I_DN + 4 * I_PL;
        f32x4 gv[4];
#pragma unroll
        for (int j = 0; j < 4; ++j) gv[j] = ((const f32x4*)g1)[lane + 64 * j];
        for (int pass = 0; pass < 2; ++pass) {
        if ((wave < 3) == (pass == 0)) {
        for (int it = gw; it < NITEMS; it += NGW) {
            int r = it;
            if (r < I_IN) { p0_transpose_item(w_in, D, 2048, WIN_T, nullptr, nullptr, scr, r, lane); continue; } r -= I_IN;
            if (r < I_OUT) { p0_transpose_item(w_out, D, D, WOUT_T, nullptr, nullptr, scr, r, lane); continue; } r -= I_OUT;
            if (r < I_UP) { p0_transpose_item(w_up, D, FF, WUP_T, g2, nullptr, scr, r, lane); continue; } r -= I_UP;
            if (r < I_DN) { p0_transpose_item(w_down, FF, D, WDOWN_T, nullptr, nullptr, scr, r, lane); continue; } r -= I_DN;
            const int gi = r / I_PL; r -= gi * I_PL;
            p0_transpose_item(w_pool + (size_t)gi * 16384, 128, 128, WPOOL_T + (size_t)gi * 16384, nullptr, pool_scale + gi * 128, scr, r, lane);
        }
        } else {
        for (int m = gw; m < M; m += NGW) {
            const f32x4* xr = (const f32x4*)(x + (size_t)m * D) + lane; f32x4 v[4]; float s = 0.f;
#pragma unroll
            for (int j = 0; j < 4; ++j) { v[j] = xr[64 * j]; s += (v[j].x * v[j].x + v[j].y * v[j].y) + (v[j].z * v[j].z + v[j].w * v[j].w); }
            const float rstd = __builtin_amdgcn_rsqf(wave_sum(s) * (1.f / D) + 1e-6f);
            if (lane == 0) RSTD1[m] = rstd;
            u32x2* o8 = (u32x2*)(XN + (size_t)m * D) + lane;
#pragma unroll
            for (int j = 0; j < 4; ++j) { const f32x4 y = v[j] * rstd * gv[j]; u32x2 w; w.x = cvt_pk_bf16(y.x, y.y); w.y = cvt_pk_bf16(y.z, y.w); o8[64 * j] = w; }
        }
        } }
    }
    SEAM(0);
    if (IN(1)) REP(1) {
        { pg8::Gemm g{XN, WIN_T, M, NPROJ, D, D}; pg8::StaticOrder S; S.init(M, NPROJ, G, bx); pg8::EpiProj E{PROJ, NPROJ, KIMG};
          pg8::gemm_phase<pg8::EpiProj, pg8::StaticOrder, true, true>(lds, g, S, E); }
        { pg8::Gemm g{XN, WIN_T + (size_t)NPROJ * D, M, 512, D, D}; pg8::StaticOrder S; S.init(M, 512, G, bx); pg8::EpiVT E{VT};
          pg8::gemm_phase<pg8::EpiVT, pg8::StaticOrder, true, true>(lds, g, S, E); }
    }
    SEAM(1);
    if (IN(2)) REP(2) {
        const bool pre = (vcu < 256);
        if (pre) {
            const int bh = vcu >> 2, s0 = (vcu & 3) * 8, krlo = min(max(2 * s0 - 4, 0), 55);
            const char* kimg = (const char*)KIMG + (size_t)bh * (64 * 8192) + tid * 16; const char* vimg = (const char*)VT + (size_t)bh * (64 * 8192) + tid * 16;
            ATT_BAR();
#pragma unroll
            for (int ii = 0; ii < 9; ++ii) { const int row = krlo + ii, slot = row % 9; ATT_GLDS(kimg + (size_t)row * 8192, A_K + slot * 8192 + wave * 1024); ATT_GLDS(vimg + (size_t)row * 8192, A_V + slot * 8192 + wave * 1024); }
        }
        pool_wave_group(PROJ, WPOOL_T, CAT, wave & 3, vcu * 2 + (wave >> 2), G * 2, lane);
        attn_phase(lds, PROJ, KIMG, VT, CAT, rpb, vcu, G, tid, lane, wave, pre);
        __syncthreads();
    }
    SEAM(2);
    if (IN(3)) REP(3) {
        pg8::Gemm g{CAT, WOUT_T, M, D, D, D}; pg8::StaticOrder S; S.init(M, D, G, bx);
        LAS float* rt3 = (LAS float*)(lds + 131072); LAS float* gt3 = rt3 + 512;
        pg8::Unit ua, ub; const bool two = (G == 256) && S.next(0, ua) && S.next(1, ub);
        int gok = 1;
        if (two) { rt3[tid] = 1.0f / RSTD1[((tid < 256) ? ua.pm : ub.pm) * 256 + (tid & 255)];
            const float ga = g1[tid], gb = g1[tid + 512]; gt3[tid] = 1.0f / ga; gt3[tid + 512] = 1.0f / gb; gok = (fabsf(ga) > 1e-3f) && (fabsf(gb) > 1e-3f); }
        gok = __syncthreads_and(gok);
        if (two && gok) { pg8::EpiRes1N E{XN, X1B, SSQ, rt3, gt3, ua.pm}; pg8::gemm_phase<pg8::EpiRes1N, pg8::StaticOrder, true, true>(lds, g, S, E); }
        else { pg8::EpiRes1 E{x, X1B, SSQ}; pg8::gemm_phase<pg8::EpiRes1, pg8::StaticOrder, true, true>(lds, g, S, E); }
    }
    SEAM(3);
    if (IN(4)) REP(4) {
        pg8::Gemm g{X1B, WUP_T, M, FF, D, D}; pg8::StaticOrder S; S.init(M, FF, G, bx);
        pg8::Unit ua, ub; const bool two = (G == 256) && S.next(0, ua) && S.next(4, ub);
        LAS float* rl = (LAS float*)(lds + 131072);
        if (two) { const int row = ((tid < 256) ? ua.pm : ub.pm) * 256 + (tid & 255); const f32x4* sp = (const f32x4*)(SSQ + (size_t)row * 16);
            const f32x4 p = (sp[0] + sp[1]) + (sp[2] + sp[3]); rl[tid] = __builtin_amdgcn_rsqf(((p[0] + p[1]) + (p[2] + p[3])) * (1.0f / 1024.0f) + 1e-6f); }
        __syncthreads();
        pg8::EpiUp E{HB, SSQ, rl, two ? ua.pm : -1};
        pg8::gemm_phase<pg8::EpiUp, pg8::StaticOrder, true, true>(lds, g, S, E);
    }
    SEAM(4);
    if (IN(5)) REP(5) {
        pg8::Gemm g{HB, WDOWN_T, M, D, FF, pg8::EpiUp::HP}; pg8::StaticOrder S; S.init(M, D, G, bx); pg8::EpiY E{(bf16_t*)(ws + WS_Y)};
        pg8::gemm_phase<pg8::EpiY, pg8::StaticOrder, false, true>(lds, g, S, E);
    }
    SEAM(5);
    if (IN(6)) {
        const bf16_t* YB = (const bf16_t*)(ws + WS_Y);
        f32x4 gv[4];
#pragma unroll
        for (int j = 0; j < 2; ++j) { gv[2 * j] = ((const f32x4*)gf)[2 * lane + 128 * j]; gv[2 * j + 1] = ((const f32x4*)gf)[2 * lane + 128 * j + 1]; }
        for (int m = gw; m < M; m += NGW) {
            const u32x4* xr = (const u32x4*)(X1B + (size_t)m * D) + lane; const u32x4* yr = (const u32x4*)(YB + (size_t)m * D) + lane;
            const u32x4 w0 = xr[0], w1 = xr[64], y0 = yr[0], y1 = yr[64];
            const f32x4 a0 = (f32x4){bf_lo(w0.x), bf_hi(w0.x), bf_lo(w0.y), bf_hi(w0.y)} + (f32x4){bf_lo(y0.x), bf_hi(y0.x), bf_lo(y0.y), bf_hi(y0.y)};
            const f32x4 a1 = (f32x4){bf_lo(w0.z), bf_hi(w0.z), bf_lo(w0.w), bf_hi(w0.w)} + (f32x4){bf_lo(y0.z), bf_hi(y0.z), bf_lo(y0.w), bf_hi(y0.w)};
            const f32x4 a2 = (f32x4){bf_lo(w1.x), bf_hi(w1.x), bf_lo(w1.y), bf_hi(w1.y)} + (f32x4){bf_lo(y1.x), bf_hi(y1.x), bf_lo(y1.y), bf_hi(y1.y)};
            const f32x4 a3 = (f32x4){bf_lo(w1.z), bf_hi(w1.z), bf_lo(w1.w), bf_hi(w1.w)} + (f32x4){bf_lo(y1.z), bf_hi(y1.z), bf_lo(y1.w), bf_hi(y1.w)};
            float s = ((a0.x * a0.x + a0.y * a0.y) + (a0.z * a0.z + a0.w * a0.w)) + ((a1.x * a1.x + a1.y * a1.y) + (a1.z * a1.z + a1.w * a1.w))
                    + ((a2.x * a2.x + a2.y * a2.y) + (a2.z * a2.z + a2.w * a2.w)) + ((a3.x * a3.x + a3.y * a3.y) + (a3.z * a3.z + a3.w * a3.w));
            const float rstd = __builtin_amdgcn_rsqf(wave_sum(s) * (1.f / D) + 1e-6f);
            f32x4* orow = (f32x4*)(out + (size_t)m * D) + 2 * lane;
            orow[0] = a0 * rstd * gv[0]; orow[1] = a1 * rstd * gv[1]; orow[128] = a2 * rstd * gv[2]; orow[129] = a3 * rstd * gv[3];
        }
    }
#undef IN
#undef SEAM
}

extern "C" void kernel_launch(void* const* d_in, const int* in_sizes, int n_in, void* d_out, int out_size, void* d_ws, size_t ws_size, hipStream_t stream) {
    static int grid = 0;
    if (grid == 0) {
        if (n_in != 11 || in_sizes[0] != M * D || out_size != M * D || ws_size < WS_END) { fprintf(stderr, "kernel_launch: unexpected shapes (n_in %d, in0 %d, out %d, ws %zu); nothing launched\n", n_in, n_in > 0 ? in_sizes[0] : -1, out_size, ws_size); grid = -1; return; }
        int dev = 0, cus = 0, per_cu = 0;
        if (hipGetDevice(&dev) != hipSuccess || hipDeviceGetAttribute(&cus, hipDeviceAttributeMultiprocessorCount, dev) != hipSuccess) { grid = -1; return; }
        if (hipFuncSetAttribute((const void*)mk_fwd, hipFuncAttributeMaxDynamicSharedMemorySize, LDS_BYTES) != hipSuccess) { fprintf(stderr, "kernel_launch: hipFuncSetAttribute failed\n"); grid = -1; return; }
        if (hipOccupancyMaxActiveBlocksPerMultiprocessor(&per_cu, (const void*)mk_fwd, NWAVES * 64, LDS_BYTES) != hipSuccess || per_cu < 1) { fprintf(stderr, "kernel_launch: occupancy query says %d\n", per_cu); per_cu = 1; }
        (void)hipGetLastError();
        grid = cus * 1;
    }
    if (grid < 0) return;
    Args a{};
    for (int i = 0; i < 11; ++i) a.in[i] = (const float*)d_in[i];
    a.out = (float*)d_out; a.ws = (unsigned char*)d_ws;
#if MK_N_LAUNCHES == 1
    a.lo = 0; a.hi = N_PHASES;
    if (hipMemsetAsync((char*)d_ws + WS_CTL, 0, CTL_BYTES, stream) != hipSuccess) { fprintf(stderr, "kernel_launch: memset of the barrier words failed\n"); return; }
    void* kargs[] = {&a};
    hipError_t e = hipLaunchCooperativeKernel((const void*)mk_fwd, dim3(grid), dim3(NWAVES * 64), kargs, LDS_BYTES, stream);
    if (e != hipSuccess) fprintf(stderr, "kernel_launch: cooperative launch failed: %s (grid %d)\n", hipGetErrorString(e), grid);
#else
    for (int p = 0; p < N_PHASES; ++p) { a.lo = p; a.hi = p + 1; hipLaunchKernelGGL(mk_fwd, dim3(grid), dim3(NWAVES * 64), LDS_BYTES, stream, a); }
#endif
}
```
